# Optimizing an MI355X kernel written in HIP

```python
import math
import jax, jax.numpy as jnp
from jax import lax
import numpy as np

D_MODEL = 1024
BATCH = 1
SEQ = 16384
DEPTH = 1

NSA_HEADS = 8
NSA_KV_GROUPS = 2
NSA_HPG = NSA_HEADS // NSA_KV_GROUPS
NSA_HEAD_DIM = 64
CMP_BLOCK = 32
CMP_STRIDE = 16
CMP_HIDDEN = 256
SLC_BLOCK = 64
SLC_COUNT = 16
WINDOW = 512
Q_BLOCK = 128
ROPE_THETA = 500000.0
ROPE_DIM = NSA_HEAD_DIM // 4
RET_HEADS = 4
RET_HEAD_DIM = 128
RET_CHUNK = 128
RET_ROT_BASE = 10000.0
MLP_HIDDEN = 4 * D_MODEL
NORM_EPS = 1e-6
NEG = -1e30
BIG = 1e30

NSA_Q_W = NSA_HEADS * NSA_HEAD_DIM
NSA_KV_W = NSA_KV_GROUPS * NSA_HEAD_DIM
RET_W = RET_HEADS * RET_HEAD_DIM
IN_SIZES = (NSA_Q_W, NSA_KV_W, NSA_KV_W, NSA_KV_W, NSA_KV_W, NSA_KV_W, NSA_KV_W, 3 * NSA_HEADS,
            RET_W, RET_W, RET_W, RET_W, D_MODEL, D_MODEL)
IN_WIDTH = sum(IN_SIZES)

kernel_name = "hybrid_nsa_retention_gated_block"


def rmsnorm(x, g):
    xf = x.astype(jnp.float32)
    y = xf * lax.rsqrt(jnp.mean(xf * xf, axis=-1, keepdims=True) + NORM_EPS) * g.astype(jnp.float32)
    return y.astype(x.dtype)


def rotary(x, pos, rot_dim, base):
    half = rot_dim // 2
    inv = jnp.exp(-math.log(base) * jnp.arange(half, dtype=jnp.float32) * 2.0 / rot_dim)
    ang = pos.astype(jnp.float32)[..., None] * inv
    cos, sin = jnp.cos(ang)[:, :, None, :], jnp.sin(ang)[:, :, None, :]
    xf = x.astype(jnp.float32)
    x1, x2 = xf[..., :half], xf[..., half:rot_dim]
    out = jnp.concatenate([x1 * cos - x2 * sin, x1 * sin + x2 * cos, xf[..., rot_dim:]], axis=-1)
    return out.astype(x.dtype)


def nsa_mixer(q, kc, vc, ks, vs, kw, vw, gates, pe_k, pe_v, ck_w1, ck_w2, cv_w1, cv_w2):
    S = q.shape[0]
    dt = q.dtype
    G, HPG, dh = NSA_KV_GROUPS, NSA_HPG, NSA_HEAD_DIM
    n_cmp = (S - CMP_BLOCK) // CMP_STRIDE + 1
    n_slc = S // SLC_BLOCK
    n_sel = min(SLC_COUNT, n_slc)
    n_qb = S // Q_BLOCK
    scale = dh ** -0.5

    cmp_idx = jnp.arange(n_cmp)[:, None] * CMP_STRIDE + jnp.arange(CMP_BLOCK)[None, :]

    def compress(k, pe, w1, w2):
        blk = k[cmp_idx] + pe[None, :, None, :]
        blk = blk.transpose(0, 2, 1, 3).reshape(n_cmp, G, CMP_BLOCK * dh)
        return jax.nn.silu(blk @ w1) @ w2

    k_cmp = compress(kc, pe_k, ck_w1, ck_w2)
    v_cmp = compress(vc, pe_v, cv_w1, cv_w2)
    cmp_start = cmp_idx[:, 0]
    cmp_end = cmp_idx[:, -1]
    slc_start = jnp.arange(n_slc) * SLC_BLOCK
    overlap = jnp.clip(jnp.minimum(cmp_start[:, None] + CMP_BLOCK, slc_start[None, :] + SLC_BLOCK)
                       - jnp.maximum(cmp_start[:, None], slc_start[None, :]), 0, None)
    overlap = overlap.astype(jnp.float32) / CMP_BLOCK

    ks_b = ks.reshape(n_slc, SLC_BLOCK, G, dh).transpose(2, 0, 1, 3)
    vs_b = vs.reshape(n_slc, SLC_BLOCK, G, dh).transpose(2, 0, 1, 3)
    kw_pad = jnp.pad(kw, ((WINDOW, 0), (0, 0), (0, 0)))
    vw_pad = jnp.pad(vw, ((WINDOW, 0), (0, 0), (0, 0)))

    qg = q.reshape(S, G, HPG, dh)
    gg = jax.nn.sigmoid(gates.astype(jnp.float32)).reshape(S, G, HPG, 3)
    g_idx = jnp.arange(G)[:, None, None]
    blk_j = jnp.arange(n_slc)

    def block(b):
        s0 = b * Q_BLOCK
        qi = lax.dynamic_slice_in_dim(qg, s0, Q_BLOCK, 0)
        gi = lax.dynamic_slice_in_dim(gg, s0, Q_BLOCK, 0)
        t = s0 + jnp.arange(Q_BLOCK)

        sc = jnp.einsum('qghd,cgd->gqhc', qi, k_cmp).astype(jnp.float32) * scale
        valid = cmp_end[None, :] <= t[:, None]
        p_c = jax.nn.softmax(jnp.where(valid[None, :, None, :], sc, NEG), axis=-1)
        p_c = p_c * jnp.any(valid, axis=-1)[None, :, None, None].astype(jnp.float32)
        o_c = jnp.einsum('gqhc,cgd->qghd', p_c.astype(dt), v_cmp)

        imp = jnp.einsum('gqhc,cj->gqj', p_c, overlap)
        cur = t // SLC_BLOCK
        forced = (blk_j[None] == 0) | (blk_j[None] == cur[:, None]) | (blk_j[None] == cur[:, None] - 1)
        future = blk_j[None] > cur[:, None]
        imp = jnp.where(forced[None], BIG, jnp.where(future[None], NEG, imp))
        _, sel = lax.top_k(imp, n_sel)

        k_sel = ks_b[g_idx, sel].reshape(G, Q_BLOCK, n_sel * SLC_BLOCK, dh)
        v_sel = vs_b[g_idx, sel].reshape(G, Q_BLOCK, n_sel * SLC_BLOCK, dh)
        k_pos = (sel[..., None] * SLC_BLOCK + jnp.arange(SLC_BLOCK)).reshape(G, Q_BLOCK, n_sel * SLC_BLOCK)
        ss = jnp.einsum('qghd,gqkd->gqhk', qi, k_sel).astype(jnp.float32) * scale
        smask = (k_pos <= t[None, :, None])[:, :, None, :]
        p_s = jax.nn.softmax(jnp.where(smask, ss, NEG), axis=-1)
        o_s = jnp.einsum('gqhk,gqkd->qghd', p_s.astype(dt), v_sel)

        k_win = lax.dynamic_slice_in_dim(kw_pad, s0, WINDOW + Q_BLOCK, 0)
        v_win = lax.dynamic_slice_in_dim(vw_pad, s0, WINDOW + Q_BLOCK, 0)
        w_pos = s0 - WINDOW + jnp.arange(WINDOW + Q_BLOCK)
        wmask = (w_pos[None] <= t[:, None]) & (w_pos[None] > t[:, None] - WINDOW) & (w_pos[None] >= 0)
        sw = jnp.einsum('qghd,kgd->gqhk', qi, k_win).astype(jnp.float32) * scale
        p_w = jax.nn.softmax(jnp.where(wmask[None, :, None, :], sw, NEG), axis=-1)
        o_w = jnp.einsum('gqhk,kgd->qghd', p_w.astype(dt), v_win)

        o = gi[..., 0:1] * o_c + gi[..., 1:2] * o_s + gi[..., 2:3] * o_w
        return o.reshape(Q_BLOCK, NSA_HEADS * dh).astype(dt)

    out = lax.map(block, jnp.arange(n_qb))
    return out.reshape(S, NSA_HEADS * dh)


def retention(q, k, v, pos):
    B, S = q.shape[0], q.shape[1]
    H, d, C = RET_HEADS, RET_HEAD_DIM, RET_CHUNK
    q = rotary(q, pos, d, RET_ROT_BASE).astype(jnp.float32)
    k = rotary(k, pos, d, RET_ROT_BASE).astype(jnp.float32) * (d ** -0.5)
    v = v.astype(jnp.float32)
    n_c = S // C

    def chunks(a):
        return a.reshape(B, n_c, C, H, d).transpose(1, 0, 3, 2, 4)

    log_g = jnp.log(1.0 - jnp.exp2(-5.0 - jnp.arange(H, dtype=jnp.float32)))
    n = jnp.arange(C, dtype=jnp.float32)
    rel = n[:, None] - n[None, :]
    dmat = jnp.where(rel >= 0, jnp.exp(log_g[:, None, None] * jnp.maximum(rel, 0.0)), 0.0)
    xi = jnp.exp(log_g[:, None] * (n + 1.0))
    zeta = jnp.exp(log_g[:, None] * (C - 1.0 - n))
    chunk_decay = jnp.exp(log_g * C)

    def step(state, inp):
        qc, kc, vc = inp
        inner = jnp.einsum('bhnm,bhme->bhne', jnp.einsum('bhnd,bhmd->bhnm', qc, kc) * dmat, vc)
        cross = jnp.einsum('bhnd,bhde->bhne', qc, state) * xi[None, :, :, None]
        state = chunk_decay[None, :, None, None] * state + jnp.einsum(
            'bhmd,bhme->bhde', kc * zeta[None, :, :, None], vc)
        return state, inner + cross

    state0 = jnp.zeros((B, H, d, d), jnp.float32)
    _, o = lax.scan(step, state0, (chunks(q), chunks(k), chunks(v)))
    o = o.transpose(1, 0, 3, 2, 4).reshape(B, S, H, d)
    return o * lax.rsqrt(jnp.mean(o * o, axis=-1, keepdims=True) + NORM_EPS)


def setup_inputs(seed: int = 0) -> dict:
    key = jax.random.key(seed)
    ks = jax.random.split(key, 20)
    f32 = jnp.float32
    nrm = lambda k, shape, s: jax.random.normal(k, shape, f32) * s
    L = DEPTH
    x = jax.random.normal(ks[0], (BATCH, SEQ, D_MODEL), f32)
    offset = jax.random.randint(ks[1], (BATCH, 1), 0, 4096, dtype=jnp.int32)
    positions = (offset + jnp.arange(SEQ, dtype=jnp.int32)[None, :]).astype(jnp.int32)
    return {
        "x": x,
        "positions": positions,
        "norm_mix": 1.0 + nrm(ks[2], (L, D_MODEL), 0.02),
        "w_in": nrm(ks[3], (L, D_MODEL, IN_WIDTH), D_MODEL ** -0.5),
        "cmp_pos_k": nrm(ks[4], (L, CMP_BLOCK, NSA_HEAD_DIM), 0.1),
        "cmp_pos_v": nrm(ks[5], (L, CMP_BLOCK, NSA_HEAD_DIM), 0.1),
        "cmp_k_w1": nrm(ks[6], (L, CMP_BLOCK * NSA_HEAD_DIM, CMP_HIDDEN), (CMP_BLOCK * NSA_HEAD_DIM) ** -0.5),
        "cmp_k_w2": nrm(ks[7], (L, CMP_HIDDEN, NSA_HEAD_DIM), CMP_HIDDEN ** -0.5),
        "cmp_v_w1": nrm(ks[8], (L, CMP_BLOCK * NSA_HEAD_DIM, CMP_HIDDEN), (CMP_BLOCK * NSA_HEAD_DIM) ** -0.5),
        "cmp_v_w2": nrm(ks[9], (L, CMP_HIDDEN, NSA_HEAD_DIM), CMP_HIDDEN ** -0.5),
        "w_proj_a": nrm(ks[10], (L, NSA_Q_W, D_MODEL), NSA_Q_W ** -0.5),
        "w_proj_b": nrm(ks[11], (L, RET_W, D_MODEL), RET_W ** -0.5),
        "w_out": nrm(ks[12], (L, D_MODEL, D_MODEL), D_MODEL ** -0.5),
        "norm_mlp": 1.0 + nrm(ks[13], (L, D_MODEL), 0.02),
        "w_up": nrm(ks[14], (L, D_MODEL, MLP_HIDDEN), D_MODEL ** -0.5),
        "w_down": nrm(ks[15], (L, MLP_HIDDEN, D_MODEL), MLP_HIDDEN ** -0.5),
        "norm_final": 1.0 + nrm(ks[16], (D_MODEL,), 0.02),
    }


def reference(x, positions, norm_mix, w_in, cmp_pos_k, cmp_pos_v, cmp_k_w1, cmp_k_w2, cmp_v_w1, cmp_v_w2,
              w_proj_a, w_proj_b, w_out, norm_mlp, w_up, w_down, norm_final):
    B, S, _ = x.shape
    offsets = np.cumsum(IN_SIZES)[:-1].tolist()
    nsa_batched = jax.vmap(nsa_mixer, in_axes=(0,) * 8 + (None,) * 6)
    for layer in range(DEPTH):
        h = rmsnorm(x, norm_mix[layer])
        (q, kc, vc, ks, vs, kw, vw, nsa_g, rq, rk, rv, rg, gate_a, gate_b) = jnp.split(
            h @ w_in[layer], offsets, axis=-1)
        heads = lambda a, n_h, d: a.reshape(B, S, n_h, d)
        q = rotary(heads(q, NSA_HEADS, NSA_HEAD_DIM), positions, ROPE_DIM, ROPE_THETA)
        kc = rotary(heads(kc, NSA_KV_GROUPS, NSA_HEAD_DIM), positions, ROPE_DIM, ROPE_THETA)
        ks = rotary(heads(ks, NSA_KV_GROUPS, NSA_HEAD_DIM), positions, ROPE_DIM, ROPE_THETA)
        kw = rotary(heads(kw, NSA_KV_GROUPS, NSA_HEAD_DIM), positions, ROPE_DIM, ROPE_THETA)
        vc = heads(vc, NSA_KV_GROUPS, NSA_HEAD_DIM)
        vs = heads(vs, NSA_KV_GROUPS, NSA_HEAD_DIM)
        vw = heads(vw, NSA_KV_GROUPS, NSA_HEAD_DIM)
        nsa_out = nsa_batched(q, kc, vc, ks, vs, kw, vw, nsa_g.reshape(B, S, NSA_HEADS, 3),
                              cmp_pos_k[layer], cmp_pos_v[layer], cmp_k_w1[layer], cmp_k_w2[layer],
                              cmp_v_w1[layer], cmp_v_w2[layer])
        ret = retention(heads(rq, RET_HEADS, RET_HEAD_DIM), heads(rk, RET_HEADS, RET_HEAD_DIM),
                        heads(rv, RET_HEADS, RET_HEAD_DIM), positions)
        ret_out = (jax.nn.silu(rg.astype(jnp.float32)) * ret.reshape(B, S, RET_W)).astype(x.dtype)
        mix = (jax.nn.sigmoid(gate_a) * (nsa_out @ w_proj_a[layer])
               + jax.nn.sigmoid(gate_b) * (ret_out @ w_proj_b[layer]))
        x = x + mix @ w_out[layer]
        h = rmsnorm(x, norm_mlp[layer])
        x = x + jnp.square(jax.nn.relu(h @ w_up[layer])) @ w_down[layer]
    return rmsnorm(x, norm_final)
```

```cpp
#include <hip/hip_runtime.h>
#include <cstdio>
#include <cstdint>

#ifndef EPI1_MASK
#define EPI1_MASK 31
#endif
#define EPI1_EN(k) ((EPI1_MASK >> (k)) & 1)
#ifndef PHASE_MASK
#define PHASE_MASK 0x7ff
#endif
constexpr int S = 16384, D = 1024, FF = 4096, NVIRT = 5632;
constexpr int INW = 5400;
constexpr float NORM_EPS = 1e-6f;
constexpr float QSCALE = 0.125f * 1.4426950408889634f;
constexpr float KSC_RET = 0.08838834764831845f;
constexpr float NEGF = -1e30f, BIGF = 1e30f;

constexpr size_t MiB = 1u << 20;
constexpr size_t WS_CTL = 0, CTL_ZERO_BYTES = 1 * MiB;
constexpr size_t WS_RSTD1 = 1 * MiB;
constexpr size_t WS_KCMP = 1 * MiB + 256 * 1024;
constexpr size_t WS_VCMPT = 1 * MiB + 512 * 1024;
constexpr size_t WS_W2K = 1 * MiB + 768 * 1024;
constexpr size_t WS_W2V = 1 * MiB + 832 * 1024;
constexpr size_t WS_WIN = 2 * MiB;
constexpr size_t WS_WPA = 13 * MiB, WS_WPB = 14 * MiB;
constexpr size_t WS_WOUT = 15 * MiB;
constexpr size_t WS_WUP = 17 * MiB;
constexpr size_t WS_WDN = 25 * MiB;
constexpr size_t WS_W1K = 33 * MiB, WS_W1V = 34 * MiB;
constexpr size_t WS_GATES = 35 * MiB;
constexpr size_t WS_XB = 37 * MiB;
constexpr size_t WS_Q = 69 * MiB;
constexpr size_t WS_KC = 85 * MiB, WS_VC = 89 * MiB, WS_KS = 93 * MiB, WS_VST = 97 * MiB, WS_KW = 101 * MiB, WS_VWT = 105 * MiB;
constexpr size_t WS_RQ = 109 * MiB, WS_RK = 125 * MiB, WS_RKT = 141 * MiB, WS_RVT = 157 * MiB, WS_RG = 173 * MiB;
constexpr size_t WS_SGA = 189 * MiB, WS_SGB = 221 * MiB;
constexpr size_t WS_MIX = 141 * MiB;
constexpr size_t WS_HMID = 69 * MiB;
constexpr size_t WS_END = 253 * MiB;
constexpr size_t DO_ST = 0, DO_NSA = 16 * MiB, DO_RET = 32 * MiB;
constexpr int CW_BAR = 4096;
constexpr int CW_SSQ2 = 16384, CW_SSQ3 = 32768;
static_assert((CW_SSQ3 + S) * 4 <= (int)CTL_ZERO_BYTES, "ctl");

constexpr int RING_BYTES = 131072;
constexpr int LDSCTL_OFF = RING_BYTES, MISC_OFF = LDSCTL_OFF + 320;
constexpr int LDS_BYTES = 147456;

namespace pg8 {
#define PG8_LAS __attribute__((address_space(3)))
typedef unsigned short bf16_t;
typedef short bf16x8 __attribute__((ext_vector_type(8)));
typedef float f32x4 __attribute__((ext_vector_type(4)));
typedef unsigned u32x4 __attribute__((ext_vector_type(4)));
constexpr int BM = 256, BK = 64, HALF = 128, HTB = HALF * BK * 2  , STAGE_BYTES = 8 * HTB, NXCD = 8, WGM = 8;

__host__ __device__ __forceinline__ int lds_byte(int r, int c) { const int st = (r >> 4) * 2 + (c >> 5), rr = r & 15, cc = c & 31, ob = rr * 64 + cc * 2; return st * 1024 + (ob ^ (((ob >> 9) & 1) << 5)); }
__host__ __device__ __forceinline__ void stage_rc(int b, int& R, int& C) { const int st = b / 1024, sb = b % 1024, swz = sb ^ (((sb >> 9) & 1) << 5); R = (st >> 1) * 16 + swz / 64; C = (st & 1) * 32 + (swz % 64) / 2; }
__host__ __device__ __forceinline__ int perm32(int rho) { const int n = rho >> 4, i = rho & 15; return 8 * (i >> 2) + 4 * n + (i & 3); }
struct Unit { int pm, pn, sel; };
struct Gemm { const bf16_t* A0; const bf16_t* A1; const bf16_t* B0; const bf16_t* B1; int K; };
struct StaticOrder {
    int nM, nN, nwg, G, c;
    __host__ __device__ void init(int M, int N, int G_, int c_) { nM = M / BM; nN = N / BM; nwg = nM * nN; G = G_; c = c_; }
    __host__ __device__ bool next(int i, Unit& u) const {
        const long L = (long)i * G + c; if (L >= nwg) return false;
        int wgid = (int)L; { const int q = nwg / NXCD, r = nwg % NXCD, xcd = wgid % NXCD, off = wgid / NXCD; wgid = (xcd < r ? xcd * (q + 1) : r * (q + 1) + (xcd - r) * q) + off; }
        const int nig = WGM * nN, gid = wgid / nig, fm = gid * WGM, gsz = (nM - fm) < WGM ? (nM - fm) : WGM;
        u.pm = fm + ((wgid % nig) % gsz); u.pn = (wgid % nig) / gsz; u.sel = 0; return true;
    }
    __device__ __forceinline__ void a_ready(const Unit&) const {}
    __device__ __forceinline__ void done(const Unit&) const {}
};
struct PairOrder {
    StaticOrder so;
    __device__ bool next(int i, Unit& u) const { if (!so.next(i >> 1, u)) return false; u.sel = i & 1; return true; }
    __device__ __forceinline__ void a_ready(const Unit&) const {}
    __device__ __forceinline__ void done(const Unit&) const {}
};
template <class Epi, class Sched, bool ALIGN_EPI = false, bool SP2 = false>
__device__ __forceinline__ void gemm_phase(PG8_LAS unsigned char* lds, const Gemm g, const Sched& S, const Epi& E) {
    const int tid = threadIdx.x, wid = __builtin_amdgcn_readfirstlane(tid >> 6), lane = tid & 63, wr = wid >> 2, wc = wid & 3, fr = lane & 15, fq = lane >> 4;
    const int K = g.K, nt = K / BK;
    unsigned voffA[2], voffB[2];
#pragma unroll
    for (int i = 0; i < 2; ++i) { int R, C; stage_rc(tid * 16 + i * 8192, R, C); const int Rb = Epi::PERM ? ((R & ~31) + perm32(R & 31)) : R;
        voffA[i] = (unsigned)(R * K + C) * 2u; voffB[i] = (unsigned)(Rb * K + C) * 2u; }
    const size_t kstep = (size_t)(BK * 2);
    const size_t hstep = (size_t)HALF * K * 2;
    const size_t tstep = 2 * hstep;
    const unsigned ldsw = (unsigned)wid * 1024u;
    const int aoff = lds_byte(wr * 64 + fr, fq * 8), boff = lds_byte(wc * 32 + fr, fq * 8);
#define PG8_SA(b, h) (((b) * 2 + (h)) * HTB)
#define PG8_SB(b, h) ((4 + (b) * 2 + (h)) * HTB)
#define PG8_STAGE(bufoff, gbase, voff) do { _Pragma("unroll") for (int _i = 0; _i < 2; ++_i) \
        __builtin_amdgcn_global_load_lds((const unsigned*)((const char*)(gbase) + (voff)[_i]), (PG8_LAS unsigned*)(lds + (bufoff) + ldsw + _i * 8192), 16, 0, 0); } while (0)
#define PG8_LDA(dst, b, h) do { _Pragma("unroll") for (int m = 0; m < 4; ++m) _Pragma("unroll") for (int k = 0; k < 2; ++k) dst[m][k] = *(const PG8_LAS bf16x8*)(lds + PG8_SA(b, h) + aoff + m * 2048 + k * 1024); } while (0)
#define PG8_LDB(dst, b, h) do { _Pragma("unroll") for (int n = 0; n < 2; ++n) _Pragma("unroll") for (int k = 0; k < 2; ++k) dst[n][k] = *(const PG8_LAS bf16x8*)(lds + PG8_SB(b, h) + boff + n * 2048 + k * 1024); } while (0)
#define PG8_MMA(ai, bj, At, Bt) do { __builtin_amdgcn_s_setprio(1); _Pragma("unroll") for (int m = 0; m < 4; ++m) _Pragma("unroll") for (int n = 0; n < 2; ++n) _Pragma("unroll") for (int k = 0; k < 2; ++k) \
        acc[ai][bj][m][n] = __builtin_amdgcn_mfma_f32_16x16x32_bf16(Bt[n][k], At[m][k], acc[ai][bj][m][n], 0, 0, 0); __builtin_amdgcn_s_setprio(0); } while (0)
#define PG8_WAIT_V(n) asm volatile("s_waitcnt vmcnt(" #n ")" ::: "memory")
#define PG8_WAIT_L(n) asm volatile("s_waitcnt lgkmcnt(" #n ")" ::: "memory")
#define PG8_BAR __builtin_amdgcn_s_barrier()
#define PG8_SCHED __builtin_amdgcn_sched_barrier(0)
    Unit cur, nxt; int ui = 0;
    if (!S.next(0, cur)) return;
    f32x4 acc[2][2][4][2];
#pragma unroll
    for (int a = 0; a < 2; ++a)
#pragma unroll
        for (int b = 0; b < 2; ++b)
#pragma unroll
            for (int m = 0; m < 4; ++m)
#pragma unroll
                for (int n = 0; n < 2; ++n) acc[a][b][m][n] = (f32x4){0.f, 0.f, 0.f, 0.f};
    bf16x8 At[4][2], B0[2][2], B1[2][2];
    const char* cA = (const char*)(cur.sel ? g.A1 : g.A0) + (size_t)cur.pm * tstep; const char* cB = (const char*)(cur.sel ? g.B1 : g.B0) + (size_t)cur.pn * tstep;
    S.a_ready(cur);
    if constexpr (SP2) {
        PG8_STAGE(PG8_SB(0, 0), cB, voffB); PG8_STAGE(PG8_SB(0, 1), cB + hstep, voffB); PG8_STAGE(PG8_SA(0, 0), cA, voffA); PG8_STAGE(PG8_SA(0, 1), cA + hstep, voffA);
        if (wr == 1) PG8_BAR;
        PG8_WAIT_V(2); PG8_BAR;
        PG8_STAGE(PG8_SB(1, 0), cB + kstep, voffB); PG8_STAGE(PG8_SA(1, 0), cA + kstep, voffA); PG8_STAGE(PG8_SB(1, 1), cB + hstep + kstep, voffB);
        PG8_WAIT_V(6); PG8_BAR;
    } else {
        PG8_STAGE(PG8_SB(0, 0), cB, voffB); PG8_STAGE(PG8_SA(0, 0), cA, voffA); PG8_STAGE(PG8_SB(0, 1), cB + hstep, voffB); PG8_STAGE(PG8_SA(0, 1), cA + hstep, voffA);
        if (wr == 1) PG8_BAR;
        PG8_WAIT_V(4); PG8_BAR;
        PG8_STAGE(PG8_SB(1, 0), cB + kstep, voffB); PG8_STAGE(PG8_SA(1, 0), cA + kstep, voffA); PG8_STAGE(PG8_SB(1, 1), cB + hstep + kstep, voffB);
        PG8_WAIT_V(6); PG8_BAR;
    }
    for (;;) {
        const bool has_next = S.next(ui + 1, nxt);
        const char* nA = has_next ? (const char*)(nxt.sel ? g.A1 : g.A0) + (size_t)nxt.pm * tstep : cA; const char* nB = has_next ? (const char*)(nxt.sel ? g.B1 : g.B0) + (size_t)nxt.pn * tstep : cB;
        for (int t = 0; t < nt; t += 2) {
            const bool last = (t == nt - 2);
            const char* a1 = cA + (size_t)(t + 1) * kstep;
            const char* a2 = last ? nA : cA + (size_t)(t + 2) * kstep; const char* b2 = last ? nB : cB + (size_t)(t + 2) * kstep;
            const char* a3 = a2 + kstep; const char* b3 = b2 + kstep;
            if (last && has_next) S.a_ready(nxt);
            if constexpr (SP2) {
            PG8_LDB(B0, 0, 0); PG8_LDB(B1, 0, 1); PG8_SCHED; PG8_LDA(At, 0, 0); PG8_STAGE(PG8_SA(1, 1), a1 + hstep, voffA);
            PG8_WAIT_V(8); PG8_WAIT_L(0); PG8_BAR; PG8_MMA(0, 0, At, B0); PG8_MMA(0, 1, At, B1); PG8_BAR; PG8_SCHED;
            PG8_LDA(At, 0, 1); PG8_STAGE(PG8_SB(0, 0), b2, voffB); PG8_STAGE(PG8_SB(0, 1), b2 + hstep, voffB); PG8_STAGE(PG8_SA(0, 0), a2, voffA);
            PG8_WAIT_V(8); PG8_WAIT_L(0); PG8_BAR; PG8_MMA(1, 0, At, B0); PG8_MMA(1, 1, At, B1); PG8_BAR; PG8_SCHED;
            PG8_LDB(B0, 1, 0); PG8_LDB(B1, 1, 1); PG8_SCHED; PG8_LDA(At, 1, 0); PG8_STAGE(PG8_SA(0, 1), a2 + hstep, voffA);
            PG8_WAIT_V(8); PG8_WAIT_L(0); PG8_BAR; PG8_MMA(0, 0, At, B0); PG8_MMA(0, 1, At, B1); PG8_BAR; PG8_SCHED;
            PG8_LDA(At, 1, 1); PG8_STAGE(PG8_SB(1, 0), b3, voffB); PG8_STAGE(PG8_SB(1, 1), b3 + hstep, voffB); PG8_STAGE(PG8_SA(1, 0), a3, voffA);
            PG8_WAIT_V(8); PG8_WAIT_L(0); PG8_BAR; PG8_MMA(1, 0, At, B0); PG8_MMA(1, 1, At, B1); PG8_BAR; PG8_SCHED;
            } else {
            PG8_LDB(B0, 0, 0); PG8_SCHED; PG8_LDA(At, 0, 0); PG8_STAGE(PG8_SA(1, 1), a1 + hstep, voffA);
            PG8_WAIT_L(8); PG8_BAR; PG8_WAIT_L(0); PG8_MMA(0, 0, At, B0); PG8_BAR; PG8_SCHED;
            PG8_LDB(B1, 0, 1); PG8_STAGE(PG8_SB(0, 0), b2, voffB);
            PG8_BAR; PG8_WAIT_L(0); PG8_MMA(0, 1, At, B1); PG8_BAR;
            PG8_LDA(At, 0, 1); PG8_STAGE(PG8_SA(0, 0), a2, voffA);
            PG8_BAR; PG8_WAIT_L(0); PG8_MMA(1, 0, At, B0); PG8_BAR; PG8_SCHED;
            PG8_STAGE(PG8_SB(0, 1), b2 + hstep, voffB);
            PG8_WAIT_V(6); PG8_BAR; PG8_MMA(1, 1, At, B1); PG8_BAR;
            PG8_LDB(B0, 1, 0); PG8_SCHED; PG8_LDA(At, 1, 0); PG8_STAGE(PG8_SA(0, 1), a2 + hstep, voffA);
            PG8_WAIT_L(8); PG8_BAR; PG8_WAIT_L(0); PG8_MMA(0, 0, At, B0); PG8_BAR; PG8_SCHED;
            PG8_LDB(B1, 1, 1); PG8_STAGE(PG8_SB(1, 0), b3, voffB);
            PG8_BAR; PG8_WAIT_L(0); PG8_MMA(0, 1, At, B1); PG8_BAR;
            PG8_LDA(At, 1, 1); PG8_STAGE(PG8_SA(1, 0), a3, voffA);
            PG8_BAR; PG8_WAIT_L(0); PG8_MMA(1, 0, At, B0); PG8_BAR; PG8_SCHED;
            PG8_STAGE(PG8_SB(1, 1), b3 + hstep, voffB);
            PG8_WAIT_V(6); PG8_BAR; PG8_MMA(1, 1, At, B1); PG8_BAR;
            }
        }
        if constexpr (ALIGN_EPI) { if (wr == 0) PG8_BAR; }
        if constexpr (!Epi::AFTER_DRAIN) { E(acc, cur, wr, wc, fr, fq); S.done(cur); }
        if (!has_next) break;
        if (!E.keep(cur)) {
#pragma unroll
        for (int a = 0; a < 2; ++a)
#pragma unroll
            for (int b = 0; b < 2; ++b)
#pragma unroll
                for (int m = 0; m < 4; ++m)
#pragma unroll
                    for (int n = 0; n < 2; ++n) acc[a][b][m][n] = (f32x4){0.f, 0.f, 0.f, 0.f};
        }
        cur = nxt; cA = nA; cB = nB; ++ui;
        if constexpr (ALIGN_EPI) { if (wr == 1) PG8_BAR; }
    }
    PG8_WAIT_V(0);
    if constexpr (!ALIGN_EPI) { if (wr == 0) PG8_BAR; }
    PG8_BAR;
    if constexpr (Epi::AFTER_DRAIN) { E.fused(acc, cur, wr, wc, fr, fq, lds, wid, lane); S.done(cur); }
#undef PG8_SA
#undef PG8_SB
#undef PG8_STAGE
#undef PG8_LDA
#undef PG8_LDB
#undef PG8_MMA
#undef PG8_WAIT_V
#undef PG8_WAIT_L
#undef PG8_BAR
#undef PG8_SCHED
}
}

#define GAS __attribute__((address_space(1)))
#define LAS __attribute__((address_space(3)))
typedef unsigned short bf16;
typedef unsigned v4u __attribute__((ext_vector_type(4)));
typedef float f32x4 __attribute__((ext_vector_type(4)));
typedef short bf16x8 __attribute__((ext_vector_type(8)));
typedef GAS unsigned gu32;
typedef GAS unsigned long long gu64;
#define RLX_AGENT __ATOMIC_RELAXED, __HIP_MEMORY_SCOPE_AGENT
#define LDS_WAIT() asm volatile("s_waitcnt lgkmcnt(0)" ::: "memory")
#define VM_WAIT() asm volatile("s_waitcnt vmcnt(0)" ::: "memory")
__device__ __forceinline__ unsigned long long rt() { return __builtin_amdgcn_s_memrealtime(); }
__device__ __forceinline__ unsigned f2bf(float f) { unsigned u = __builtin_bit_cast(unsigned, f); return (u + 0x7fffu + ((u >> 16) & 1u)) >> 16; }
__device__ __forceinline__ unsigned pk2(float lo, float hi) { return f2bf(lo) | (f2bf(hi) << 16); }

#define XB_TMO      128
#define XB_XCNT(j)  (256  + 64 * (j))
#define XB_XSUB(j)  (1280 + 64 * (j))
#define XB_XGEN(j)  (2304 + 64 * (j))
#define XB_TOP      3328
#define XB_TOPGEN   3392
#define XCD_BAR_WORDS 3456
#define XB_SPIN_CAP (1u << 18)

__device__ __forceinline__ unsigned xb_ld(unsigned* p)              { return __hip_atomic_load(p, __ATOMIC_RELAXED, __HIP_MEMORY_SCOPE_AGENT); }
__device__ __forceinline__ unsigned xb_add(unsigned* p, unsigned v) { return __hip_atomic_fetch_add(p, v, __ATOMIC_RELAXED, __HIP_MEMORY_SCOPE_AGENT); }
__device__ __forceinline__ unsigned xb_xcc_id() { return (unsigned)__builtin_amdgcn_s_getreg((3 << 11) | 20) & 0xFu; }
#define XB_SPIN(cond, bar) do { unsigned _sp = 0; while (cond) { __builtin_amdgcn_s_sleep(1); \
    if ((++_sp & 255u) == 0u) { if (xb_ld(&(bar)[XB_TMO])) break; if (_sp > XB_SPIN_CAP) { atomicAdd(&(bar)[XB_TMO], 1u); break; } } } } while (0)

struct XcdBarrier {
    unsigned* bar; unsigned x;
    volatile LAS unsigned* st;
};

__device__ __forceinline__ XcdBarrier xcd_barrier_post(unsigned* bar, volatile LAS unsigned* st) {
    XcdBarrier b; b.bar = bar; b.x = xb_xcc_id(); b.st = st;
    if (threadIdx.x == 0) (void)xb_add(&bar[XB_XCNT(b.x)], 1u);
    return b;
}
__device__ __forceinline__ void xcd_barrier_complete(unsigned* bar, unsigned x, unsigned& nloc, unsigned& nx) {
    const unsigned G = gridDim.x * gridDim.y * gridDim.z;
    unsigned sum, cnt, mine, sp = 0u;
    for (;;) {
        sum = 0u; cnt = 0u; mine = 0u;
#pragma unroll
        for (unsigned j = 0; j < 16; ++j) { const unsigned c = xb_ld(&bar[XB_XCNT(j)]); sum += c; cnt += (c > 0u) ? 1u : 0u; mine = (j == x) ? c : mine; }
        if (sum == G) break;
        __builtin_amdgcn_s_sleep(1);
        if ((++sp & 255u) == 0u) { if (xb_ld(&bar[XB_TMO])) break; if (sp > XB_SPIN_CAP) { atomicAdd(&bar[XB_TMO], 1u); break; } }
    }
    nloc = mine > 0u ? mine : 1u; nx = cnt > 0u ? cnt : 1u;
}

__device__ __forceinline__ void xcd_barrier(const XcdBarrier& b) {
    asm volatile("s_waitcnt vmcnt(0)" ::: "memory");
    __syncthreads();
    if (threadIdx.x == 0) {
        unsigned* bar = b.bar;
        __builtin_amdgcn_s_waitcnt(0);
        unsigned nloc = b.st[0], nx = b.st[1];
        if (nloc == 0u) { xcd_barrier_complete(bar, b.x, nloc, nx); b.st[0] = nloc; b.st[1] = nx; }
        const unsigned old = xb_add(&bar[XB_XSUB(b.x)], 1u);
        const unsigned gen = old / nloc;
        if (old + 1u == (gen + 1u) * nloc) {
            __builtin_amdgcn_fence(__ATOMIC_RELEASE, "agent");
            asm volatile("s_waitcnt vmcnt(0)" ::: "memory");
            const unsigned og = xb_add(&bar[XB_TOP], 1u);
            const unsigned tg = og / nx;
            if (og + 1u == (tg + 1u) * nx) xb_add(&bar[XB_TOPGEN], 1u);
            else XB_SPIN(xb_ld(&bar[XB_TOPGEN]) == tg, bar);
            __builtin_amdgcn_fence(__ATOMIC_ACQUIRE, "agent");
            xb_add(&bar[XB_XGEN(b.x)], 1u);
            asm volatile("s_waitcnt vmcnt(0)" ::: "memory");
        } else {
            XB_SPIN(xb_ld(&bar[XB_XGEN(b.x)]) == gen, bar);
            __builtin_amdgcn_fence(__ATOMIC_ACQUIRE, "agent");
            asm volatile("s_waitcnt vmcnt(0)" ::: "memory");
        }
    }
    __syncthreads();
}

typedef float f32x16 __attribute__((ext_vector_type(16)));
typedef float f32x2_t __attribute__((ext_vector_type(2)));
typedef __bf16 bf16x2_t __attribute__((ext_vector_type(2)));
typedef unsigned u32x2 __attribute__((ext_vector_type(2)));
__device__ __forceinline__ unsigned cvtpk(float lo, float hi) { f32x2_t v = {lo, hi}; bf16x2_t b = __builtin_convertvector(v, bf16x2_t); return __builtin_bit_cast(unsigned, b); }
__device__ __forceinline__ v4u pack8(f32x4 a, f32x4 b) { v4u w; w.x = cvtpk(a[0], a[1]); w.y = cvtpk(a[2], a[3]); w.z = cvtpk(b[0], b[1]); w.w = cvtpk(b[2], b[3]); return w; }
__device__ __forceinline__ unsigned short bf1(float v) { return (unsigned short)(cvtpk(v, 0.f) & 0xffffu); }
__device__ __forceinline__ float bf2f(unsigned short b) { return __uint_as_float(((unsigned)b) << 16); }
__device__ __forceinline__ float sigmoidf_(float v) { return __builtin_amdgcn_rcpf(1.0f + __expf(-v)); }
__device__ __forceinline__ int crow(int r, int hi) { return (r & 3) + 8 * (r >> 2) + 4 * hi; }
__device__ __forceinline__ void sincos_turns(float ang, float& s, float& c) {
    double r = (double)ang * 0.15915494309189535; r = r - __builtin_rint(r); const float f = (float)r;
    s = __builtin_amdgcn_sinf(f); c = __builtin_amdgcn_cosf(f);
}
__device__ __forceinline__ float log2_gamma(int h) { return __log2f(1.0f - exp2f(-5.0f - (float)h)); }

using pg8::Unit; using pg8::bf16_t;
__host__ __device__ __forceinline__ int win_src_col(int nv) {
    if (nv < 1280) return nv;
    if (nv < 2304) { const int r = nv - 1280, sec = r >> 9, hh = (r >> 7) & 3, p = r & 127, a = p >> 5, b = (p >> 3) & 3, n = (p >> 2) & 1, j = p & 3;
        return 1304 + sec * 512 + hh * 128 + 64 * n + 16 * a + 4 * b + j; }
    if (nv < 5376) return nv + 24;
    if (nv < 5400) return 1280 + (nv - 5376);
    return -1;
}
struct Epi1 {
    static constexpr bool PERM = true, AFTER_DRAIN = false;
    unsigned char* ws; const int* pos;
    __device__ __forceinline__ bool keep(const Unit&) const { return false; }
    __device__ __forceinline__ void operator()(f32x4 (&acc)[2][2][4][2], const Unit& u, int wr, int wc, int fr, int fq) const {
        const int pn = u.pn; int rowb = u.pm * 256 + wr * 64 + fr, cl = wc * 32 + 8 * fq;
        asm volatile("" : "+v"(rowb), "+v"(cl));
        const float* rstd = (const float*)(ws + WS_RSTD1);
        if (EPI1_EN(0) && pn < 5) {
            const bool rotw = (wc & 1) == 0;
#pragma unroll
            for (int ai = 0; ai < 2; ++ai)
#pragma unroll
                for (int m = 0; m < 4; ++m) {
                    const int row = rowb + ai * 128 + m * 16; const float rs = rstd[row];
                    const float p = rotw ? (float)pos[row] : 0.f;
#pragma unroll
                    for (int bj = 0; bj < 2; ++bj) {
                        f32x4 v0 = acc[ai][bj][m][0] * rs, v1 = acc[ai][bj][m][1] * rs;
                        const bool isk = (pn < 2) || (bj == 0);
                        if (rotw && isk) {
#pragma unroll
                            for (int j = 0; j < 4; ++j) {
                                float t0 = -13.122363377404328f * (float)j; t0 = t0 * 2.0f; t0 = t0 / 16.0f;
                                float t1 = -13.122363377404328f * (float)(4 + j); t1 = t1 * 2.0f; t1 = t1 / 16.0f;
                                float s0, c0, s1, c1; sincos_turns(p * expf(t0), s0, c0); sincos_turns(p * expf(t1), s1, c1);
                                const float q0 = __shfl_xor(v0[j], 16), q1 = __shfl_xor(v1[j], 16);
                                if (fq == 0) { v0[j] = v0[j] * c0 - q0 * s0; v1[j] = v1[j] * c1 - q1 * s1; }
                                else if (fq == 1) { v0[j] = q0 * s0 + v0[j] * c0; v1[j] = q1 * s1 + v1[j] * c1; }
                            }
                        }
                        if (pn < 2) { v0 = v0 * QSCALE; v1 = v1 * QSCALE;
                            *(v4u*)((bf16_t*)(ws + WS_Q) + (size_t)row * 512 + pn * 256 + bj * 128 + cl) = pack8(v0, v1);
                        } else if (bj == 0) {
                            bf16_t* dst = (bf16_t*)(ws + (pn == 2 ? WS_KC : pn == 3 ? WS_KS : WS_KW));
                            *(v4u*)(dst + (size_t)row * 128 + cl) = pack8(v0, v1);
                        } else if (pn == 2) {
                            *(v4u*)((bf16_t*)(ws + WS_VC) + (size_t)row * 128 + cl) = pack8(v0, v1);
                        } else {
                            bf16_t* dst = (bf16_t*)(ws + (pn == 3 ? WS_VST : WS_VWT)) + (size_t)cl * S + row;
#pragma unroll
                            for (int j = 0; j < 4; ++j) { dst[(size_t)j * S] = bf1(v0[j]); dst[(size_t)(4 + j) * S] = bf1(v1[j]); }
                        }
                    }
                }
        } else if (EPI1_EN(1) && pn < 9) {
            const bool isk = pn >= 7;
#pragma unroll
            for (int ai = 0; ai < 2; ++ai)
#pragma unroll
                for (int m = 0; m < 4; ++m) {
                    const int row = rowb + ai * 128 + m * 16; const float rs = rstd[row]; const float p = (float)pos[row];
#pragma unroll
                    for (int bj = 0; bj < 2; ++bj) {
                        const int hh = ((pn - 5) & 1) * 2 + bj;
                        const f32x4 x1 = acc[ai][bj][m][0] * rs, x2 = acc[ai][bj][m][1] * rs; f32x4 o1, o2;
#pragma unroll
                        for (int j = 0; j < 4; ++j) {
                            float t = -9.210340371976184f * (float)(16 * wc + 4 * fq + j); t = t * 2.0f; t = t / 128.0f;
                            float sn, cs; sincos_turns(p * expf(t), sn, cs);
                            o1[j] = x1[j] * cs - x2[j] * sn; o2[j] = x1[j] * sn + x2[j] * cs; }
                        if (isk) { o1 = o1 * KSC_RET; o2 = o2 * KSC_RET; }
                        *(v4u*)((bf16_t*)(ws + (isk ? WS_RK : WS_RQ)) + (size_t)row * 512 + hh * 128 + cl) = pack8(o1, o2);
                        if (isk) {
                            const float zeta = exp2f((float)(127 - (row & 127)) * log2_gamma(hh));
                            bf16_t* dst = (bf16_t*)(ws + WS_RKT) + (size_t)(hh * 128 + cl) * S + row;
#pragma unroll
                            for (int j = 0; j < 4; ++j) { dst[(size_t)j * S] = bf1(o1[j] * zeta); dst[(size_t)(4 + j) * S] = bf1(o2[j] * zeta); }
                        }
                    }
                }
        } else if (EPI1_EN(2) && pn < 11) {
#pragma unroll
            for (int ai = 0; ai < 2; ++ai)
#pragma unroll
                for (int m = 0; m < 4; ++m) {
                    const int row = rowb + ai * 128 + m * 16; const float rs = rstd[row];
#pragma unroll
                    for (int bj = 0; bj < 2; ++bj) {
                        const int hh = (pn - 9) * 2 + bj; const f32x4 v0 = acc[ai][bj][m][0] * rs, v1 = acc[ai][bj][m][1] * rs;
                        bf16_t* dst = (bf16_t*)(ws + WS_RVT) + (size_t)(hh * 128 + cl) * S + row;
#pragma unroll
                        for (int j = 0; j < 4; ++j) { dst[(size_t)j * S] = bf1(v0[j]); dst[(size_t)(4 + j) * S] = bf1(v1[j]); }
                    }
                }
        } else if (EPI1_EN(3) && pn < 21) {
#pragma unroll
            for (int ai = 0; ai < 2; ++ai)
#pragma unroll
                for (int m = 0; m < 4; ++m) {
                    const int row = rowb + ai * 128 + m * 16; const float rs = rstd[row];
#pragma unroll
                    for (int bj = 0; bj < 2; ++bj) {
                        f32x4 v0 = acc[ai][bj][m][0] * rs, v1 = acc[ai][bj][m][1] * rs;
#pragma unroll
                        for (int j = 0; j < 4; ++j) { const float s0 = sigmoidf_(v0[j]), s1 = sigmoidf_(v1[j]); v0[j] = pn < 13 ? v0[j] * s0 : s0; v1[j] = pn < 13 ? v1[j] * s1 : s1; }
                        bf16_t* dst;
                        if (pn < 13) dst = (bf16_t*)(ws + WS_RG) + (size_t)row * 512 + (pn - 11) * 256;
                        else if (pn < 17) dst = (bf16_t*)(ws + WS_SGA) + (size_t)row * 1024 + (pn - 13) * 256;
                        else dst = (bf16_t*)(ws + WS_SGB) + (size_t)row * 1024 + (pn - 17) * 256;
                        *(v4u*)(dst + bj * 128 + cl) = pack8(v0, v1);
                    }
                }
        } else {
            if (EPI1_EN(4) && wc == 0) {
#pragma unroll
                for (int ai = 0; ai < 2; ++ai)
#pragma unroll
                    for (int m = 0; m < 4; ++m) {
                        const int row = rowb + ai * 128 + m * 16; const float rs = rstd[row];
                        f32x4 v0 = acc[ai][0][m][0] * rs, v1 = acc[ai][0][m][1] * rs;
#pragma unroll
                        for (int j = 0; j < 4; ++j) { v0[j] = sigmoidf_(v0[j]); v1[j] = sigmoidf_(v1[j]); }
                        float* dst = (float*)(ws + WS_GATES) + (size_t)row * 32 + cl;
                        *(f32x4*)dst = v0; *(f32x4*)(dst + 4) = v1;
                    }
            }
        }
    }
};
struct EpiMix {
    static constexpr bool PERM = true, AFTER_DRAIN = false;
    unsigned char* ws;
    __device__ __forceinline__ bool keep(const Unit& u) const { return u.sel == 0; }
    __device__ __forceinline__ void operator()(f32x4 (&acc)[2][2][4][2], const Unit& u, int wr, int wc, int fr, int fq) const {
        const int rowb = u.pm * 256 + wr * 64 + fr, colb = u.pn * 256 + wc * 32 + 8 * fq;
        const bool first = u.sel == 0;
#pragma unroll
        for (int ai = 0; ai < 2; ++ai)
#pragma unroll
            for (int m = 0; m < 4; ++m) {
                const int row = rowb + ai * 128 + m * 16;
#pragma unroll
                for (int bj = 0; bj < 2; ++bj) {
                    const size_t off = (size_t)row * 1024 + colb + bj * 128;
                    const v4u gb = *(const v4u*)((const bf16_t*)(ws + WS_SGB) + off);
                    f32x4 b0, b1;
                    b0[0] = __uint_as_float(gb.x << 16); b0[1] = __uint_as_float(gb.x & 0xffff0000u); b0[2] = __uint_as_float(gb.y << 16); b0[3] = __uint_as_float(gb.y & 0xffff0000u);
                    b1[0] = __uint_as_float(gb.z << 16); b1[1] = __uint_as_float(gb.z & 0xffff0000u); b1[2] = __uint_as_float(gb.w << 16); b1[3] = __uint_as_float(gb.w & 0xffff0000u);
                    if (first) {
                        const v4u ga = *(const v4u*)((const bf16_t*)(ws + WS_SGA) + off);
                        f32x4 a0, a1;
                        a0[0] = __uint_as_float(ga.x << 16); a0[1] = __uint_as_float(ga.x & 0xffff0000u); a0[2] = __uint_as_float(ga.y << 16); a0[3] = __uint_as_float(ga.y & 0xffff0000u);
                        a1[0] = __uint_as_float(ga.z << 16); a1[1] = __uint_as_float(ga.z & 0xffff0000u); a1[2] = __uint_as_float(ga.w << 16); a1[3] = __uint_as_float(ga.w & 0xffff0000u);
#pragma unroll
                        for (int j = 0; j < 4; ++j) { a0[j] = a0[j] * __builtin_amdgcn_rcpf(b0[j]); a1[j] = a1[j] * __builtin_amdgcn_rcpf(b1[j]); }
                        acc[ai][bj][m][0] = acc[ai][bj][m][0] * a0; acc[ai][bj][m][1] = acc[ai][bj][m][1] * a1;
                    } else {
                        *(v4u*)((bf16_t*)(ws + WS_MIX) + off) = pack8(acc[ai][bj][m][0] * b0, acc[ai][bj][m][1] * b1);
                    }
                }
            }
    }
};
template <bool WRITE_BF16> struct EpiRes {
    static constexpr bool PERM = true, AFTER_DRAIN = false;
    const float* base; float* out; bf16_t* outb; float* ssq;
    __device__ __forceinline__ bool keep(const Unit&) const { return false; }
    __device__ __forceinline__ void operator()(f32x4 (&acc)[2][2][4][2], const Unit& u, int wr, int wc, int fr, int fq) const {
        const int rowb = u.pm * 256 + wr * 64 + fr, colb = u.pn * 256 + wc * 32 + 8 * fq;
#pragma unroll
        for (int ai = 0; ai < 2; ++ai)
#pragma unroll
            for (int m = 0; m < 4; ++m) {
                const int row = rowb + ai * 128 + m * 16; float ss = 0.f;
#pragma unroll
                for (int bj = 0; bj < 2; ++bj) {
                    const size_t off = (size_t)row * 1024 + colb + bj * 128;
                    const f32x4 b0 = *(const f32x4*)(base + off), b1 = *(const f32x4*)(base + off + 4);
                    const f32x4 v0 = acc[ai][bj][m][0] + b0, v1 = acc[ai][bj][m][1] + b1;
                    *(f32x4*)(out + off) = v0; *(f32x4*)(out + off + 4) = v1;
                    if (WRITE_BF16) *(v4u*)(outb + off) = pack8(v0, v1);
                    ss += (v0[0] * v0[0] + v0[1] * v0[1]) + (v0[2] * v0[2] + v0[3] * v0[3]) + (v1[0] * v1[0] + v1[1] * v1[1]) + (v1[2] * v1[2] + v1[3] * v1[3]);
                }
                ss += __shfl_xor(ss, 16); ss += __shfl_xor(ss, 32);
                if (fq == 0) atomicAdd(ssq + row, ss);
            }
    }
};
struct EpiUp {
    static constexpr bool PERM = true, AFTER_DRAIN = false;
    const float* ssq; bf16_t* O;
    __device__ __forceinline__ bool keep(const Unit&) const { return false; }
    __device__ __forceinline__ void operator()(f32x4 (&acc)[2][2][4][2], const Unit& u, int wr, int wc, int fr, int fq) const {
        const int rowb = u.pm * 256 + wr * 64 + fr, colb = u.pn * 256 + wc * 32 + 8 * fq;
#pragma unroll
        for (int ai = 0; ai < 2; ++ai)
#pragma unroll
            for (int m = 0; m < 4; ++m) {
                const int row = rowb + ai * 128 + m * 16; const float rs = __builtin_amdgcn_rsqf(ssq[row] * (1.0f / D) + NORM_EPS);
#pragma unroll
                for (int bj = 0; bj < 2; ++bj) {
                    f32x4 v0 = acc[ai][bj][m][0] * rs, v1 = acc[ai][bj][m][1] * rs;
#pragma unroll
                    for (int j = 0; j < 4; ++j) { const float a = fmaxf(v0[j], 0.f), b = fmaxf(v1[j], 0.f); v0[j] = a * a; v1[j] = b * b; }
                    *(v4u*)(O + (size_t)row * FF + colb + bj * 128) = pack8(v0, v1);
                }
            }
    }
};

struct Frame {
    LAS unsigned char* lds;
    volatile LAS unsigned* MISC;
    gu32* ctl;
    int tid, lane, wave;
    int vcu, G;
    unsigned char* ws; unsigned char* dout;
};
__device__ __forceinline__ float wave_sum(float v) {
#pragma unroll
    for (int o = 1; o < 64; o <<= 1) v += __shfl_xor(v, o);
    return v;
}
__device__ __forceinline__ void p0_transpose_item(const float* W, int ldw, int K, bf16* WT, int n0, int k0, int srccol, const float* kscale, LAS float* scr, int lane) {
#pragma unroll 8
    for (int i = 0; i < 32; ++i) { const int kk = 2 * i + (lane >> 5); float v = 0.f;
        if (srccol >= 0) { v = W[(size_t)(k0 + kk) * ldw + srccol]; if (kscale) v *= kscale[k0 + kk]; }
        scr[kk * 33 + (lane & 31)] = v; }
    LDS_WAIT(); asm volatile("" ::: "memory");
    const int c = lane & 7;
#pragma unroll
    for (int j = 0; j < 4; ++j) { const int n = (lane >> 3) + 8 * j; const LAS float* s = scr + (8 * c) * 33 + n;
        v4u o; o.x = cvtpk(s[0 * 33], s[1 * 33]); o.y = cvtpk(s[2 * 33], s[3 * 33]); o.z = cvtpk(s[4 * 33], s[5 * 33]); o.w = cvtpk(s[6 * 33], s[7 * 33]);
        *(GAS v4u*)(WT + (size_t)(n0 + n) * K + k0 + 8 * c) = o; }
    LDS_WAIT(); asm volatile("" ::: "memory");
}
struct Args { const void* in[17]; float* out; unsigned char* ws; };

__device__ __forceinline__ void p0_prologue(Frame& F, const Args& a) {
    LAS float* scr = (LAS float*)(F.lds + F.wave * 16384);
    const int gw = F.vcu * 8 + F.wave, NGW = F.G * 8, lane = F.lane;
    constexpr int I_WIN = 16 * (NVIRT / 32), I_PA = 8 * 32, I_PB = 8 * 32, I_OUT = 16 * 32, I_UP = 16 * 128, I_DN = 64 * 32, I_W1 = 32 * 8, I_W2 = 4 * 2;
    constexpr int NITEMS = I_WIN + I_PA + I_PB + I_OUT + I_UP + I_DN + 2 * I_W1 + 2 * I_W2;
    for (int it = gw; it < NITEMS; it += NGW) {
        int r = it;
        if (r < I_WIN) { const int nb = r % (NVIRT / 32), kb = r / (NVIRT / 32); p0_transpose_item((const float*)a.in[3], INW, 1024, (bf16*)(F.ws + WS_WIN), nb * 32, kb * 64, win_src_col(nb * 32 + (lane & 31)), (const float*)a.in[2], scr, lane); continue; } r -= I_WIN;
        if (r < I_PA) { const int nb = r % 32, kb = r / 32; p0_transpose_item((const float*)a.in[10], 1024, 512, (bf16*)(F.ws + WS_WPA), nb * 32, kb * 64, nb * 32 + (lane & 31), nullptr, scr, lane); continue; } r -= I_PA;
        if (r < I_PB) { const int nb = r % 32, kb = r / 32; p0_transpose_item((const float*)a.in[11], 1024, 512, (bf16*)(F.ws + WS_WPB), nb * 32, kb * 64, nb * 32 + (lane & 31), nullptr, scr, lane); continue; } r -= I_PB;
        if (r < I_OUT) { const int nb = r % 32, kb = r / 32; p0_transpose_item((const float*)a.in[12], 1024, 1024, (bf16*)(F.ws + WS_WOUT), nb * 32, kb * 64, nb * 32 + (lane & 31), nullptr, scr, lane); continue; } r -= I_OUT;
        if (r < I_UP) { const int nb = r % 128, kb = r / 128; p0_transpose_item((const float*)a.in[14], 4096, 1024, (bf16*)(F.ws + WS_WUP), nb * 32, kb * 64, nb * 32 + (lane & 31), (const float*)a.in[13], scr, lane); continue; } r -= I_UP;
        if (r < I_DN) { const int nb = r % 32, kb = r / 32; p0_transpose_item((const float*)a.in[15], 1024, 4096, (bf16*)(F.ws + WS_WDN), nb * 32, kb * 64, nb * 32 + (lane & 31), nullptr, scr, lane); continue; } r -= I_DN;
        if (r < I_W1) { const int nb = r % 8, kb = r / 8; p0_transpose_item((const float*)a.in[6], 256, 2048, (bf16*)(F.ws + WS_W1K), nb * 32, kb * 64, nb * 32 + (lane & 31), nullptr, scr, lane); continue; } r -= I_W1;
        if (r < I_W1) { const int nb = r % 8, kb = r / 8; p0_transpose_item((const float*)a.in[8], 256, 2048, (bf16*)(F.ws + WS_W1V), nb * 32, kb * 64, nb * 32 + (lane & 31), nullptr, scr, lane); continue; } r -= I_W1;
        if (r < I_W2) { const int nb = r % 2, kb = r / 2; p0_transpose_item((const float*)a.in[7], 64, 256, (bf16*)(F.ws + WS_W2K), nb * 32, kb * 64, nb * 32 + (lane & 31), nullptr, scr, lane); continue; } r -= I_W2;
        { const int nb = r % 2, kb = r / 2; p0_transpose_item((const float*)a.in[9], 64, 256, (bf16*)(F.ws + WS_W2V), nb * 32, kb * 64, nb * 32 + (lane & 31), nullptr, scr, lane); }
    }
    const float* x = (const float*)a.in[0]; bf16* xb = (bf16*)(F.ws + WS_XB); float* rstd = (float*)(F.ws + WS_RSTD1);
    for (int m = gw; m < S; m += NGW) {
        const GAS f32x4* xr = (const GAS f32x4*)(x + (size_t)m * D) + lane;
        f32x4 v[4]; float s = 0.f;
#pragma unroll
        for (int j = 0; j < 4; ++j) { v[j] = xr[64 * j]; s += (v[j].x * v[j].x + v[j].y * v[j].y) + (v[j].z * v[j].z + v[j].w * v[j].w); }
        s = wave_sum(s);
        GAS unsigned long long* o8 = (GAS unsigned long long*)(xb + (size_t)m * D) + lane;
#pragma unroll
        for (int j = 0; j < 4; ++j) o8[64 * j] = (unsigned long long)cvtpk(v[j].x, v[j].y) | ((unsigned long long)cvtpk(v[j].z, v[j].w) << 32);
        if (lane == 0) rstd[m] = 1.0f / sqrtf(s * (1.0f / D) + NORM_EPS);
    }
}

__device__ __forceinline__ void p2_compress_item(Frame& F, const Args& a, int item) {
    const int kind = item >> 6, tile = item & 63, lane = F.lane, w = F.wave, l31 = lane & 31, hi = lane >> 5;
    const int R = 32 * tile + l31, g = R >> 10, c = R & 1023, cc = c < 1023 ? c : 1022;
    const bf16* src = (const bf16*)(F.ws + (kind ? WS_VC : WS_KC)) + (size_t)(16 * cc) * 128 + g * 64 + 8 * hi;
    const float* pe = (const float*)a.in[kind ? 5 : 4] + 8 * hi;
    const bf16* w1t = (const bf16*)(F.ws + (kind ? WS_W1V : WS_W1K)) + (size_t)(32 * w + l31) * 2048 + 8 * hi;
    f32x16 acc = {};
#pragma unroll 4
    for (int ks = 0; ks < 128; ++ks) {
        const int l = ks >> 2, d = 16 * (ks & 3);
        const bf16x8 af = *(const bf16x8*)(w1t + 16 * ks);
        const v4u braw = *(const v4u*)(src + (size_t)l * 128 + d);
        const f32x4 pe0 = *(const f32x4*)(pe + l * 64 + d), pe1 = *(const f32x4*)(pe + l * 64 + d + 4);
        v4u bp;
        bp.x = cvtpk(__uint_as_float(braw.x << 16) + pe0[0], __uint_as_float(braw.x & 0xffff0000u) + pe0[1]);
        bp.y = cvtpk(__uint_as_float(braw.y << 16) + pe0[2], __uint_as_float(braw.y & 0xffff0000u) + pe0[3]);
        bp.z = cvtpk(__uint_as_float(braw.z << 16) + pe1[0], __uint_as_float(braw.z & 0xffff0000u) + pe1[1]);
        bp.w = cvtpk(__uint_as_float(braw.w << 16) + pe1[2], __uint_as_float(braw.w & 0xffff0000u) + pe1[3]);
        acc = __builtin_amdgcn_mfma_f32_32x32x16_bf16(af, __builtin_bit_cast(bf16x8, bp), acc, 0, 0, 0);
    }
    LAS bf16* H = (LAS bf16*)F.lds;
#pragma unroll
    for (int q4 = 0; q4 < 4; ++q4) {
        float v[4];
#pragma unroll
        for (int j = 0; j < 4; ++j) { const float t = acc[4 * q4 + j]; v[j] = t * sigmoidf_(t); }
        u32x2 o; o.x = cvtpk(v[0], v[1]); o.y = cvtpk(v[2], v[3]);
        *(LAS u32x2*)(H + l31 * 264 + 32 * w + 8 * q4 + 4 * hi) = o;
    }
    __syncthreads();
    if (w < 2) {
        const bf16* w2t = (const bf16*)(F.ws + (kind ? WS_W2V : WS_W2K)) + (size_t)(32 * w + l31) * 256 + 8 * hi;
        f32x16 o2 = {};
#pragma unroll
        for (int ks = 0; ks < 16; ++ks) {
            const bf16x8 af = *(const bf16x8*)(w2t + 16 * ks);
            const bf16x8 bfr = *(const LAS bf16x8*)(H + l31 * 264 + 16 * ks + 8 * hi);
            o2 = __builtin_amdgcn_mfma_f32_32x32x16_bf16(af, bfr, o2, 0, 0, 0);
        }
        if (kind == 0) {
            bf16* dst = (bf16*)(F.ws + WS_KCMP) + (size_t)c * 128 + g * 64 + 32 * w + 4 * hi;
#pragma unroll
            for (int q4 = 0; q4 < 4; ++q4) { u32x2 o; o.x = cvtpk(o2[4 * q4], o2[4 * q4 + 1]); o.y = cvtpk(o2[4 * q4 + 2], o2[4 * q4 + 3]); if (c == 1023) { o.x = 0u; o.y = 0u; } *(u32x2*)(dst + 8 * q4) = o; }
        } else {
            bf16* dst = (bf16*)(F.ws + WS_VCMPT) + (size_t)(g * 64 + 32 * w + 4 * hi) * 1024 + c;
#pragma unroll
            for (int r = 0; r < 16; ++r) dst[(size_t)((r & 3) + 8 * (r >> 2)) * 1024] = c == 1023 ? (bf16)0 : bf1(o2[r]);
        }
    }
    __syncthreads();
}
__device__ __forceinline__ void p2_kv_item(Frame& F, int item) {
    const int c = item >> 2, h = item & 3, lane = F.lane, w = F.wave, l31 = lane & 31, hi = lane >> 5;
    const int mt = w >> 1;
    const bf16* vt = (const bf16*)(F.ws + WS_RVT) + (size_t)(h * 128 + 32 * mt + l31) * S + 128 * c + 8 * hi;
    float* kv = (float*)(F.ws + WS_XB) + (size_t)(c * 4 + h) * 16384;
#pragma unroll
    for (int t2 = 0; t2 < 2; ++t2) {
        const int nt = 2 * (w & 1) + t2;
        const bf16* kt = (const bf16*)(F.ws + WS_RKT) + (size_t)(h * 128 + 32 * nt + l31) * S + 128 * c + 8 * hi;
        f32x16 acc = {};
#pragma unroll
        for (int ks = 0; ks < 8; ++ks) acc = __builtin_amdgcn_mfma_f32_32x32x16_bf16(*(const bf16x8*)(vt + 16 * ks), *(const bf16x8*)(kt + 16 * ks), acc, 0, 0, 0);
#pragma unroll
        for (int r = 0; r < 16; ++r) kv[(size_t)(32 * mt + crow(r, hi)) * 128 + 32 * nt + l31] = acc[r];
    }
}
__device__ __forceinline__ void p3_scan(Frame& F) {
    const int gt = (F.vcu * 8 + F.wave) * 64 + F.lane, NT = F.G * 512;
    const float* kv = (const float*)(F.ws + WS_XB); bf16* st = (bf16*)(F.dout + DO_ST);
    for (int i = gt; i < 65536; i += NT) {
        const int h = i >> 14; const float dec = exp2f(128.0f * log2_gamma(h));
        float s = 0.f;
        for (int c0 = 0; c0 < 128; c0 += 16) {
            float t[16];
#pragma unroll
            for (int u = 0; u < 16; ++u) t[u] = kv[(size_t)(c0 + u) * 65536 + i];
#pragma unroll
            for (int u = 0; u < 16; ++u) { st[(size_t)(c0 + u) * 65536 + i] = bf1(s); s = dec * s + t[u]; }
        }
    }
}
__device__ __forceinline__ void p4_ret_item(Frame& F, int item, int wq) {
    const int c = item >> 2, h = item & 3, lane = F.lane, l31 = lane & 31, hi = lane >> 5;
    const int n = 32 * wq + l31; const size_t tok = (size_t)128 * c + n;
    const float lg = log2_gamma(h);
    bf16x8 qf[8];
    { const bf16* qp = (const bf16*)(F.ws + WS_RQ) + tok * 512 + h * 128 + 8 * hi;
#pragma unroll
      for (int ks = 0; ks < 8; ++ks) qf[ks] = *(const bf16x8*)(qp + 16 * ks); }
    f32x16 acc[4];
    { const bf16* sp = (const bf16*)(F.dout + DO_ST) + (size_t)(c * 4 + h) * 16384 + (size_t)l31 * 128 + 8 * hi;
#pragma unroll
      for (int mt = 0; mt < 4; ++mt) { f32x16 t = {};
#pragma unroll
          for (int ks = 0; ks < 8; ++ks) t = __builtin_amdgcn_mfma_f32_32x32x16_bf16(*(const bf16x8*)(sp + (size_t)mt * 4096 + 16 * ks), qf[ks], t, 0, 0, 0);
          acc[mt] = t; }
      const float xi = exp2f((float)(n + 1) * lg);
#pragma unroll
      for (int mt = 0; mt < 4; ++mt) acc[mt] = acc[mt] * xi; }
    for (int u = 0; u <= wq; ++u) {
        const bf16* kp = (const bf16*)(F.ws + WS_RK) + ((size_t)128 * c + 32 * u + l31) * 512 + h * 128 + 8 * hi;
        f32x16 p = {};
#pragma unroll
        for (int ks = 0; ks < 8; ++ks) p = __builtin_amdgcn_mfma_f32_32x32x16_bf16(*(const bf16x8*)(kp + 16 * ks), qf[ks], p, 0, 0, 0);
        unsigned pk[8];
#pragma unroll
        for (int r = 0; r < 16; r += 2) {
            const int m0 = 32 * u + crow(r, hi), m1 = m0 + 1;
            const float d0 = n >= m0 ? exp2f((float)(n - m0) * lg) : 0.f, d1 = n >= m1 ? exp2f((float)(n - m1) * lg) : 0.f;
            pk[r >> 1] = cvtpk(p[r] * d0, p[r + 1] * d1);
        }
        const bf16* vp = (const bf16*)(F.ws + WS_RVT) + (size_t)(h * 128 + l31) * S + (size_t)128 * c + 32 * u + 4 * hi;
#pragma unroll
        for (int s2 = 0; s2 < 2; ++s2) {
            v4u bw; bw.x = pk[4 * s2]; bw.y = pk[4 * s2 + 1]; bw.z = pk[4 * s2 + 2]; bw.w = pk[4 * s2 + 3];
#pragma unroll
            for (int mt = 0; mt < 4; ++mt) {
                const bf16* vv = vp + (size_t)(32 * mt) * S + 16 * s2;
                const u32x2 a0 = *(const u32x2*)vv, a1 = *(const u32x2*)(vv + 8);
                v4u aw; aw.x = a0.x; aw.y = a0.y; aw.z = a1.x; aw.w = a1.y;
                acc[mt] = __builtin_amdgcn_mfma_f32_32x32x16_bf16(__builtin_bit_cast(bf16x8, aw), __builtin_bit_cast(bf16x8, bw), acc[mt], 0, 0, 0);
            }
        }
    }
    float ss = 0.f;
#pragma unroll
    for (int mt = 0; mt < 4; ++mt)
#pragma unroll
        for (int r = 0; r < 16; ++r) ss += acc[mt][r] * acc[mt][r];
    ss += __shfl_xor(ss, 32);
    const float rn = 1.0f / sqrtf(ss * (1.0f / 128.0f) + NORM_EPS);
    const bf16* gp = (const bf16*)(F.ws + WS_RG) + tok * 512 + h * 128 + 4 * hi;
    bf16* op = (bf16*)(F.dout + DO_RET) + tok * 512 + h * 128 + 4 * hi;
#pragma unroll
    for (int mt = 0; mt < 4; ++mt)
#pragma unroll
        for (int q4 = 0; q4 < 4; ++q4) {
            const u32x2 gr = *(const u32x2*)(gp + 32 * mt + 8 * q4);
            u32x2 o;
            o.x = cvtpk(acc[mt][4 * q4] * rn * __uint_as_float(gr.x << 16), acc[mt][4 * q4 + 1] * rn * __uint_as_float(gr.x & 0xffff0000u));
            o.y = cvtpk(acc[mt][4 * q4 + 2] * rn * __uint_as_float(gr.y << 16), acc[mt][4 * q4 + 3] * rn * __uint_as_float(gr.y & 0xffff0000u));
            *(u32x2*)(op + 32 * mt + 8 * q4) = o;
        }
}

template <int MODE>
__device__ __forceinline__ bool nsa_valid(int idx, int t, bool colsel) {
    if (MODE == 0) return 16 * idx + 31 <= t;
    if (MODE == 1) return idx <= t && idx > t - 512;
    return colsel && idx <= t;
}
__device__ __forceinline__ f32x16 nsa_qk(const bf16* krow, const bf16x8 (&qf)[4]) {
    f32x16 s = {};
#pragma unroll
    for (int ks = 0; ks < 4; ++ks) s = __builtin_amdgcn_mfma_f32_32x32x16_bf16(*(const bf16x8*)(krow + 16 * ks), qf[ks], s, 0, 0, 0);
    return s;
}
template <int MODE> __device__ __forceinline__ void nsa_stats(const f32x16& s, int keybase, int t, bool colsel, int hi, float& m, float& l) {
    float tm = NEGF;
#pragma unroll
    for (int r = 0; r < 16; ++r) { const bool v = nsa_valid<MODE>(keybase + crow(r, hi), t, colsel); tm = fmaxf(tm, v ? s[r] : NEGF); }
    const float mn = fmaxf(m, tm); float acc = l * exp2f(m - mn);
#pragma unroll
    for (int r = 0; r < 16; ++r) { const bool v = nsa_valid<MODE>(keybase + crow(r, hi), t, colsel); acc += v ? exp2f(s[r] - mn) : 0.f; }
    m = mn; l = acc;
}
__device__ __forceinline__ void nsa_merge_halves(float& m, float& l) {
    const float m2 = __shfl_xor(m, 32), l2 = __shfl_xor(l, 32), M = fmaxf(m, m2);
    const float L = l * exp2f(m - M) + l2 * exp2f(m2 - M);
    m = M; l = L > 0.f ? 1.0f / L : 0.f;
}
template <int MODE> __device__ __forceinline__ void nsa_probs(const f32x16& s, int keybase, int t, bool colsel, int hi, float M, float invl, float (&p)[16]) {
#pragma unroll
    for (int r = 0; r < 16; ++r) { const bool v = nsa_valid<MODE>(keybase + crow(r, hi), t, colsel); p[r] = v ? exp2f(s[r] - M) * invl : 0.f; }
}
__device__ __forceinline__ void nsa_pv(f32x16 (&o)[2], const bf16* vt, size_t ldv, const float (&p)[16], float gate) {
#pragma unroll
    for (int s2 = 0; s2 < 2; ++s2) {
        v4u bw; bw.x = cvtpk(p[8 * s2] * gate, p[8 * s2 + 1] * gate); bw.y = cvtpk(p[8 * s2 + 2] * gate, p[8 * s2 + 3] * gate);
        bw.z = cvtpk(p[8 * s2 + 4] * gate, p[8 * s2 + 5] * gate); bw.w = cvtpk(p[8 * s2 + 6] * gate, p[8 * s2 + 7] * gate);
#pragma unroll
        for (int mt = 0; mt < 2; ++mt) {
            const bf16* vv = vt + (size_t)(32 * mt) * ldv + 16 * s2;
            const u32x2 a0 = *(const u32x2*)vv, a1 = *(const u32x2*)(vv + 8);
            v4u aw; aw.x = a0.x; aw.y = a0.y; aw.z = a1.x; aw.w = a1.y;
            o[mt] = __builtin_amdgcn_mfma_f32_32x32x16_bf16(__builtin_bit_cast(bf16x8, aw), __builtin_bit_cast(bf16x8, bw), o[mt], 0, 0, 0);
        }
    }
}
constexpr int NSA_IMP_OFF = 0, NSA_SEL_OFF = 65536;
__device__ __forceinline__ void p4_nsa_item(Frame& F, int T, int g) {
    const int lane = F.lane, w = F.wave, l31 = lane & 31, hi = lane >> 5, ql = l31 >> 2, hd = l31 & 3;
    const int t0 = 64 * T, t = t0 + 8 * w + ql, cur = T;
    LAS float* imp = (LAS float*)(F.lds + NSA_IMP_OFF) + (8 * w) * 256;
    LAS int* selb = (LAS int*)(F.lds + NSA_SEL_OFF) + w * 128;
#pragma unroll
    for (int i = 0; i < 32; ++i) imp[i * 64 + lane] = 0.f;
    bf16x8 qf[4];
    { const bf16* qp = (const bf16*)(F.ws + WS_Q) + (size_t)t * 512 + (g * 4 + hd) * 64 + 8 * hi;
#pragma unroll
      for (int ks = 0; ks < 4; ++ks) qf[ks] = *(const bf16x8*)(qp + 16 * ks); }
    const float* gt = (const float*)(F.ws + WS_GATES) + (size_t)t * 32 + (g * 4 + hd) * 3;
    const float g_cmp = gt[0], g_sel = gt[1], g_win = gt[2];
    f32x16 o[2]; o[0] = (f32x16){}; o[1] = (f32x16){};
    {
        const bf16* kc = (const bf16*)(F.ws + WS_KCMP) + (size_t)l31 * 128 + g * 64 + 8 * hi;
        const bf16* vc = (const bf16*)(F.ws + WS_VCMPT) + (size_t)(g * 64 + l31) * 1024 + 4 * hi;
        const int ntile = (4 * T + 2) / 32 + 1;
        float m = NEGF, l = 0.f;
        for (int i = 0; i < ntile; ++i) { const f32x16 s = nsa_qk(kc + (size_t)(32 * i) * 128, qf); nsa_stats<0>(s, 32 * i, t, true, hi, m, l); }
        nsa_merge_halves(m, l);
        for (int i = 0; i < ntile; ++i) {
            const f32x16 s = nsa_qk(kc + (size_t)(32 * i) * 128, qf);
            float p[16]; nsa_probs<0>(s, 32 * i, t, true, hi, m, l, p);
#pragma unroll
            for (int q4 = 0; q4 < 4; ++q4) {
                float a = (p[4 * q4] + p[4 * q4 + 1]) + p[4 * q4 + 2], b = 0.5f * p[4 * q4 + 3];
                a += __shfl_xor(a, 1); a += __shfl_xor(a, 2); b += __shfl_xor(b, 1); b += __shfl_xor(b, 2);
                const int j = 8 * i + 2 * q4 + hi;
                if (hd == 0) { __hip_atomic_fetch_add(imp + ql * 256 + j, a + b, __ATOMIC_RELAXED, __HIP_MEMORY_SCOPE_WORKGROUP);
                               if (j + 1 < 256) __hip_atomic_fetch_add(imp + ql * 256 + j + 1, b, __ATOMIC_RELAXED, __HIP_MEMORY_SCOPE_WORKGROUP); }
            }
            nsa_pv(o, vc + 32 * i, 1024, p, g_cmp);
        }
    }
    const int nsel = cur + 1 < 16 ? cur + 1 : 16;
    LDS_WAIT();
    for (int qq = 0; qq < 8; ++qq) {
        float v[4];
#pragma unroll
        for (int i = 0; i < 4; ++i) { const int j = lane + 64 * i; float x = imp[qq * 256 + j];
            if (j == 0 || j == cur || j == cur - 1) x = BIGF; if (j > cur) x = NEGF; v[i] = x; }
        for (int k = 0; k < nsel; ++k) {
            float bv = v[0]; int bj = lane;
#pragma unroll
            for (int i = 1; i < 4; ++i) if (v[i] > bv) { bv = v[i]; bj = lane + 64 * i; }
#pragma unroll
            for (int off = 32; off >= 1; off >>= 1) { const float ov = __shfl_xor(bv, off); const int oj = __shfl_xor(bj, off); if (ov > bv || (ov == bv && oj < bj)) { bv = ov; bj = oj; } }
            if (lane == 0) selb[qq * 16 + k] = bj;
#pragma unroll
            for (int i = 0; i < 4; ++i) if (lane + 64 * i == bj) v[i] = -3e38f;
        }
    }
    LDS_WAIT();
    {
        const bf16* ksb = (const bf16*)(F.ws + WS_KS) + (size_t)l31 * 128 + g * 64 + 8 * hi;
        const bf16* vsb = (const bf16*)(F.ws + WS_VST) + (size_t)(g * 64 + l31) * S + 4 * hi;
        float m = NEGF, l = 0.f;
        for (int qq = 0; qq < 8; ++qq) { const bool colsel = ql == qq;
            for (int k = 0; k < nsel; ++k) { const int j = __builtin_amdgcn_readfirstlane(selb[qq * 16 + k]);
#pragma unroll
                for (int u = 0; u < 2; ++u) { const int kb = 64 * j + 32 * u; const f32x16 s = nsa_qk(ksb + (size_t)kb * 128, qf); nsa_stats<2>(s, kb, t, colsel, hi, m, l); } } }
        nsa_merge_halves(m, l);
        for (int qq = 0; qq < 8; ++qq) { const bool colsel = ql == qq;
            for (int k = 0; k < nsel; ++k) { const int j = __builtin_amdgcn_readfirstlane(selb[qq * 16 + k]);
#pragma unroll
                for (int u = 0; u < 2; ++u) { const int kb = 64 * j + 32 * u; const f32x16 s = nsa_qk(ksb + (size_t)kb * 128, qf);
                    float p[16]; nsa_probs<2>(s, kb, t, colsel, hi, m, l, p); nsa_pv(o, vsb + kb, S, p, g_sel); } } }
    }
    {
        const bf16* kwb = (const bf16*)(F.ws + WS_KW) + (size_t)l31 * 128 + g * 64 + 8 * hi;
        const bf16* vwb = (const bf16*)(F.ws + WS_VWT) + (size_t)(g * 64 + l31) * S + 4 * hi;
        const int kb0 = t0 - 512 < 0 ? 0 : t0 - 512, kb1 = t0 + 64;
        float m = NEGF, l = 0.f;
        for (int kb = kb0; kb < kb1; kb += 32) { const f32x16 s = nsa_qk(kwb + (size_t)kb * 128, qf); nsa_stats<1>(s, kb, t, true, hi, m, l); }
        nsa_merge_halves(m, l);
        for (int kb = kb0; kb < kb1; kb += 32) { const f32x16 s = nsa_qk(kwb + (size_t)kb * 128, qf);
            float p[16]; nsa_probs<1>(s, kb, t, true, hi, m, l, p); nsa_pv(o, vwb + kb, S, p, g_win); }
    }
    bf16* op = (bf16*)(F.dout + DO_NSA) + (size_t)t * 512 + (g * 4 + hd) * 64 + 4 * hi;
#pragma unroll
    for (int mt = 0; mt < 2; ++mt)
#pragma unroll
        for (int q4 = 0; q4 < 4; ++q4) { u32x2 v; v.x = cvtpk(o[mt][4 * q4], o[mt][4 * q4 + 1]); v.y = cvtpk(o[mt][4 * q4 + 2], o[mt][4 * q4 + 3]); *(u32x2*)(op + 32 * mt + 8 * q4) = v; }
}

__global__ void __launch_bounds__(512, 2) fwd_megakernel(Args args) {
    extern __shared__ __attribute__((aligned(16))) unsigned char lds[];
    Frame F;
    F.lds = (LAS unsigned char*)lds;
    F.MISC = (volatile LAS unsigned*)(F.lds + MISC_OFF);
    F.tid = threadIdx.x; F.lane = F.tid & 63; F.wave = __builtin_amdgcn_readfirstlane(F.tid >> 6);
    F.G = gridDim.x; { const int bx = blockIdx.x; F.vcu = (F.G % 8 == 0) ? (bx % 8) * (F.G / 8) + bx / 8 : bx; }
    F.ws = args.ws; F.dout = (unsigned char*)args.out;
    F.ctl = (gu32*)(args.ws + WS_CTL);
    for (int u = F.tid; u < (LDS_BYTES - LDSCTL_OFF) / 4; u += 512) ((LAS unsigned*)(F.lds + LDSCTL_OFF))[u] = 0u;
    __syncthreads();
    XcdBarrier bar = xcd_barrier_post((unsigned*)(F.ctl + CW_BAR), F.MISC + 8);
    unsigned char* ws = args.ws;
    const int G = F.G, bid = blockIdx.x;

    if (PHASE_MASK & 1) p0_prologue(F, args);
    xcd_barrier(bar);
    if (PHASE_MASK & 2) {
        pg8::Gemm g{(const bf16_t*)(ws + WS_XB), (const bf16_t*)(ws + WS_XB), (const bf16_t*)(ws + WS_WIN), (const bf16_t*)(ws + WS_WIN), D};
        pg8::StaticOrder So; So.init(S, NVIRT, G, bid);
        Epi1 E{ws, (const int*)args.in[1]};
        pg8::gemm_phase<Epi1, pg8::StaticOrder, true, true>(F.lds, g, So, E);
    }
    xcd_barrier(bar);
    if (PHASE_MASK & 4) { for (int it = bid; it < 128; it += G) p2_compress_item(F, args, it);
    for (int it = bid; it < 512; it += G) p2_kv_item(F, it); }
    xcd_barrier(bar);
    if (PHASE_MASK & 8) p3_scan(F);
    xcd_barrier(bar);
    if (PHASE_MASK & 16) { for (int it = bid; it < 512; it += G) { const int T = it < 256 ? it : 511 - it, g = it >> 8; p4_nsa_item(F, T, g); } }
    if (PHASE_MASK & 1024) { for (int pi = bid; pi < 256; pi += G) p4_ret_item(F, 2 * pi + (F.wave >> 2), F.wave & 3); }
    xcd_barrier(bar);
    if (PHASE_MASK & 32) {
        pg8::Gemm g{(const bf16_t*)(F.dout + DO_NSA), (const bf16_t*)(F.dout + DO_RET), (const bf16_t*)(ws + WS_WPA), (const bf16_t*)(ws + WS_WPB), 512};
        pg8::PairOrder Po; Po.so.init(S, D, G, bid);
        EpiMix E{ws};
        pg8::gemm_phase<EpiMix, pg8::PairOrder, false, true>(F.lds, g, Po, E);
    }
    xcd_barrier(bar);
    if (PHASE_MASK & 64) {
        pg8::Gemm g{(const bf16_t*)(ws + WS_MIX), (const bf16_t*)(ws + WS_MIX), (const bf16_t*)(ws + WS_WOUT), (const bf16_t*)(ws + WS_WOUT), D};
        pg8::StaticOrder So; So.init(S, D, G, bid);
        EpiRes<true> E{(const float*)args.in[0], args.out, (bf16_t*)(ws + WS_XB), (float*)(F.ctl + CW_SSQ2)};
        pg8::gemm_phase<EpiRes<true>, pg8::StaticOrder, false, true>(F.lds, g, So, E);
    }
    xcd_barrier(bar);
    if (PHASE_MASK & 128) {
        pg8::Gemm g{(const bf16_t*)(ws + WS_XB), (const bf16_t*)(ws + WS_XB), (const bf16_t*)(ws + WS_WUP), (const bf16_t*)(ws + WS_WUP), D};
        pg8::StaticOrder So; So.init(S, FF, G, bid);
        EpiUp E{(const float*)(F.ctl + CW_SSQ2), (bf16_t*)(ws + WS_HMID)};
        pg8::gemm_phase<EpiUp, pg8::StaticOrder, true, true>(F.lds, g, So, E);
    }
    xcd_barrier(bar);
    if (PHASE_MASK & 256) {
        pg8::Gemm g{(const bf16_t*)(ws + WS_HMID), (const bf16_t*)(ws + WS_HMID), (const bf16_t*)(ws + WS_WDN), (const bf16_t*)(ws + WS_WDN), FF};
        pg8::StaticOrder So; So.init(S, D, G, bid);
        EpiRes<false> E{args.out, args.out, nullptr, (float*)(F.ctl + CW_SSQ3)};
        pg8::gemm_phase<EpiRes<false>, pg8::StaticOrder, false, true>(F.lds, g, So, E);
    }
    xcd_barrier(bar);
    if (PHASE_MASK & 512) {
        const float* gf = (const float*)args.in[16]; const float* ssq = (const float*)(F.ctl + CW_SSQ3);
        const unsigned tmo = __hip_atomic_load((unsigned*)(F.ctl + CW_BAR) + XB_TMO, RLX_AGENT);
        const int gw = F.vcu * 8 + F.wave, NGW = G * 8;
        for (int m = gw; m < S; m += NGW) {
            GAS f32x4* xr = (GAS f32x4*)(args.out + (size_t)m * D) + F.lane;
            float rs = 1.0f / sqrtf(ssq[m] * (1.0f / D) + NORM_EPS);
            if (tmo) rs = __builtin_nanf("");
#pragma unroll
            for (int j = 0; j < 4; ++j) { const f32x4 gv = *((const f32x4*)gf + F.lane + 64 * j); xr[64 * j] = xr[64 * j] * rs * gv; }
        }
    }
}

extern "C" void kernel_launch(void* const* d_in, const int* in_sizes, int n_in, void* d_out, int out_size, void* d_ws, size_t ws_size, hipStream_t stream) {
    static int grid = 0;
    if (grid == 0) {
        if (n_in != 17 || in_sizes[0] != S * D || out_size != S * D || ws_size < WS_END) { fprintf(stderr, "kernel_launch: unexpected shapes (n_in %d, in0 %d, out %d, ws %zu)\n", n_in, n_in > 0 ? in_sizes[0] : -1, out_size, ws_size); grid = -1; return; }
        int dev = 0, cus = 0, per_cu = 0;
        if (hipGetDevice(&dev) != hipSuccess || hipDeviceGetAttribute(&cus, hipDeviceAttributeMultiprocessorCount, dev) != hipSuccess) { grid = -1; return; }
        if (hipFuncSetAttribute((const void*)fwd_megakernel, hipFuncAttributeMaxDynamicSharedMemorySize, LDS_BYTES) != hipSuccess) { fprintf(stderr, "kernel_launch: hipFuncSetAttribute failed\n"); grid = -1; return; }
        if (hipOccupancyMaxActiveBlocksPerMultiprocessor(&per_cu, (const void*)fwd_megakernel, 512, LDS_BYTES) != hipSuccess || per_cu < 1)
            fprintf(stderr, "kernel_launch: note: occupancy query reports %d workgroups per CU\n", per_cu);
        (void)hipGetLastError();
        grid = cus;
    }
    if (grid < 0) return;
    if (hipMemsetAsync((char*)d_ws + WS_CTL, 0, CTL_ZERO_BYTES, stream) != hipSuccess) { fprintf(stderr, "kernel_launch: memset failed\n"); return; }
    Args a{};
    for (int i = 0; i < 17; ++i) a.in[i] = d_in[i];
    a.out = (float*)d_out; a.ws = (unsigned char*)d_ws;
    hipLaunchKernelGGL(fwd_megakernel, dim3(grid), dim3(512), LDS_BYTES, stream, a);
    const hipError_t le = hipPeekAtLastError();
    if (le != hipSuccess) fprintf(stderr, "kernel_launch: launch failed: %s\n", hipGetErrorName(le));
}
```

```cpp
#include <hip/hip_runtime.h>
#include <cstdio>
#include <cstdint>

#ifndef EPI1_MASK
#define EPI1_MASK 31
#endif
#define EPI1_EN(k) ((EPI1_MASK >> (k)) & 1)
#ifndef DBG_ESCALE
#define DBG_ESCALE 1.0f
#endif
#ifndef DBG_XSCALE
#define DBG_XSCALE 100.0f
#endif
#ifndef DBG_NSA_SRC
#define DBG_NSA_SRC DO_NSA
#endif
#ifndef PHASE_MASK
#define PHASE_MASK 0x7ff
#endif
constexpr int S = 16384, D = 1024, FF = 4096, NVIRT = 5632;
constexpr int INW = 5400;
constexpr float NORM_EPS = 1e-6f;
constexpr float QSCALE = 0.125f * 1.4426950408889634f;
constexpr float KSC_RET = 0.08838834764831845f;
constexpr float NEGF = -1e30f, BIGF = 1e30f;

constexpr size_t MiB = 1u << 20;
constexpr size_t WS_CTL = 0, CTL_ZERO_BYTES = 1 * MiB;
constexpr size_t WS_RSTD1 = 1 * MiB;
constexpr size_t WS_KCMP = 1 * MiB + 256 * 1024;
constexpr size_t WS_VCMPT = 1 * MiB + 512 * 1024;
constexpr size_t WS_W2K = 1 * MiB + 768 * 1024;
constexpr size_t WS_W2V = 1 * MiB + 832 * 1024;
constexpr size_t WS_WIN = 2 * MiB;
constexpr size_t WS_WPA = 13 * MiB, WS_WPB = 14 * MiB;
constexpr size_t WS_WOUT = 15 * MiB;
constexpr size_t WS_WUP = 17 * MiB;
constexpr size_t WS_WDN = 25 * MiB;
constexpr size_t WS_W1K = 33 * MiB, WS_W1V = 34 * MiB;
constexpr size_t WS_GATES = 35 * MiB;
constexpr size_t WS_XB = 37 * MiB;
constexpr size_t WS_Q = 69 * MiB;
constexpr size_t WS_KC = 85 * MiB, WS_VC = 89 * MiB, WS_KS = 93 * MiB, WS_VST = 97 * MiB, WS_KW = 101 * MiB, WS_VWT = 105 * MiB;
constexpr size_t WS_RQ = 109 * MiB, WS_RK = 125 * MiB, WS_RKT = 141 * MiB, WS_RVT = 157 * MiB, WS_RG = 173 * MiB;
constexpr size_t WS_SGA = 189 * MiB, WS_SGB = 221 * MiB;
constexpr size_t WS_MIX = 141 * MiB;
constexpr size_t WS_HMID = 69 * MiB;
constexpr size_t WS_END = 253 * MiB;
constexpr size_t DO_ST = 0, DO_NSA = 16 * MiB, DO_RET = 32 * MiB;
constexpr int CW_BAR = 4096;
constexpr int CW_SSQ2 = 16384, CW_SSQ3 = 32768;
static_assert((CW_SSQ3 + S) * 4 <= (int)CTL_ZERO_BYTES, "ctl");

constexpr int RING_BYTES = 131072;
constexpr int LDSCTL_OFF = RING_BYTES, MISC_OFF = LDSCTL_OFF + 320;
constexpr int LDS_BYTES = 147456;

namespace pg8 {
#define PG8_LAS __attribute__((address_space(3)))
typedef unsigned short bf16_t;
typedef short bf16x8 __attribute__((ext_vector_type(8)));
typedef float f32x4 __attribute__((ext_vector_type(4)));
typedef unsigned u32x4 __attribute__((ext_vector_type(4)));
constexpr int BM = 256, BK = 64, HALF = 128, HTB = HALF * BK * 2  , STAGE_BYTES = 8 * HTB, NXCD = 8, WGM = 8;

__host__ __device__ __forceinline__ int lds_byte(int r, int c) { const int st = (r >> 4) * 2 + (c >> 5), rr = r & 15, cc = c & 31, ob = rr * 64 + cc * 2; return st * 1024 + (ob ^ (((ob >> 9) & 1) << 5)); }
__host__ __device__ __forceinline__ void stage_rc(int b, int& R, int& C) { const int st = b / 1024, sb = b % 1024, swz = sb ^ (((sb >> 9) & 1) << 5); R = (st >> 1) * 16 + swz / 64; C = (st & 1) * 32 + (swz % 64) / 2; }
__host__ __device__ __forceinline__ int perm32(int rho) { const int n = rho >> 4, i = rho & 15; return 8 * (i >> 2) + 4 * n + (i & 3); }
struct Unit { int pm, pn, sel; };
struct Gemm { const bf16_t* A0; const bf16_t* A1; const bf16_t* B0; const bf16_t* B1; int K; };
struct StaticOrder {
    int nM, nN, nwg, G, c;
    __host__ __device__ void init(int M, int N, int G_, int c_) { nM = M / BM; nN = N / BM; nwg = nM * nN; G = G_; c = c_; }
    __host__ __device__ bool next(int i, Unit& u) const {
        const long L = (long)i * G + c; if (L >= nwg) return false;
        int wgid = (int)L; { const int q = nwg / NXCD, r = nwg % NXCD, xcd = wgid % NXCD, off = wgid / NXCD; wgid = (xcd < r ? xcd * (q + 1) : r * (q + 1) + (xcd - r) * q) + off; }
        const int nig = WGM * nN, gid = wgid / nig, fm = gid * WGM, gsz = (nM - fm) < WGM ? (nM - fm) : WGM;
        u.pm = fm + ((wgid % nig) % gsz); u.pn = (wgid % nig) / gsz; u.sel = 0; return true;
    }
    __device__ __forceinline__ void a_ready(const Unit&) const {}
    __device__ __forceinline__ void done(const Unit&) const {}
};
struct PairOrder {
    StaticOrder so;
    __device__ bool next(int i, Unit& u) const { if (!so.next(i >> 1, u)) return false; u.sel = i & 1; return true; }
    __device__ __forceinline__ void a_ready(const Unit&) const {}
    __device__ __forceinline__ void done(const Unit&) const {}
};
template <class Epi, class Sched, bool ALIGN_EPI = false, bool SP2 = false>
__device__ __forceinline__ void gemm_phase(PG8_LAS unsigned char* lds, const Gemm g, const Sched& S, const Epi& E) {
    int tid_ = threadIdx.x; asm volatile("" : "+v"(tid_));
    const int tid = tid_, wid = __builtin_amdgcn_readfirstlane(tid >> 6), lane = tid & 63, wr = wid >> 2, wc = wid & 3, fr = lane & 15, fq = lane >> 4;
    const int K = g.K, nt = K / BK;
    unsigned voffA[2], voffB[2];
#pragma unroll
    for (int i = 0; i < 2; ++i) { int R, C; stage_rc(tid * 16 + i * 8192, R, C); const int Rb = Epi::PERM ? ((R & ~31) + perm32(R & 31)) : R;
        voffA[i] = (unsigned)(R * K + C) * 2u; voffB[i] = (unsigned)(Rb * K + C) * 2u; }
    const size_t kstep = (size_t)(BK * 2);
    const size_t hstep = (size_t)HALF * K * 2;
    const size_t tstep = 2 * hstep;
    const unsigned ldsw = (unsigned)wid * 1024u;
    const int aoff = lds_byte(wr * 64 + fr, fq * 8), boff = lds_byte(wc * 32 + fr, fq * 8);
#define PG8_SA(b, h) (((b) * 2 + (h)) * HTB)
#define PG8_SB(b, h) ((4 + (b) * 2 + (h)) * HTB)
#define PG8_STAGE(bufoff, gbase, voff) do { _Pragma("unroll") for (int _i = 0; _i < 2; ++_i) \
        __builtin_amdgcn_global_load_lds((const unsigned*)((const char*)(gbase) + (voff)[_i]), (PG8_LAS unsigned*)(lds + (bufoff) + ldsw + _i * 8192), 16, 0, 0); } while (0)
#define PG8_LDA(dst, b, h) do { _Pragma("unroll") for (int m = 0; m < 4; ++m) _Pragma("unroll") for (int k = 0; k < 2; ++k) dst[m][k] = *(const PG8_LAS bf16x8*)(lds + PG8_SA(b, h) + aoff + m * 2048 + k * 1024); } while (0)
#define PG8_LDB(dst, b, h) do { _Pragma("unroll") for (int n = 0; n < 2; ++n) _Pragma("unroll") for (int k = 0; k < 2; ++k) dst[n][k] = *(const PG8_LAS bf16x8*)(lds + PG8_SB(b, h) + boff + n * 2048 + k * 1024); } while (0)
#define PG8_MMA(ai, bj, At, Bt) do { __builtin_amdgcn_s_setprio(1); _Pragma("unroll") for (int m = 0; m < 4; ++m) _Pragma("unroll") for (int n = 0; n < 2; ++n) _Pragma("unroll") for (int k = 0; k < 2; ++k) \
        acc[ai][bj][m][n] = __builtin_amdgcn_mfma_f32_16x16x32_bf16(Bt[n][k], At[m][k], acc[ai][bj][m][n], 0, 0, 0); __builtin_amdgcn_s_setprio(0); } while (0)
#define PG8_WAIT_V(n) asm volatile("s_waitcnt vmcnt(" #n ")" ::: "memory")
#define PG8_WAIT_L(n) asm volatile("s_waitcnt lgkmcnt(" #n ")" ::: "memory")
#define PG8_BAR __builtin_amdgcn_s_barrier()
#define PG8_SCHED __builtin_amdgcn_sched_barrier(0)
    Unit cur, nxt; int ui = 0;
    if (!S.next(0, cur)) return;
    f32x4 acc[2][2][4][2];
#pragma unroll
    for (int a = 0; a < 2; ++a)
#pragma unroll
        for (int b = 0; b < 2; ++b)
#pragma unroll
            for (int m = 0; m < 4; ++m)
#pragma unroll
                for (int n = 0; n < 2; ++n) acc[a][b][m][n] = (f32x4){0.f, 0.f, 0.f, 0.f};
    bf16x8 At[4][2], B0[2][2], B1[2][2];
    const char* cA = (const char*)(cur.sel ? g.A1 : g.A0) + (size_t)cur.pm * tstep; const char* cB = (const char*)(cur.sel ? g.B1 : g.B0) + (size_t)cur.pn * tstep;
    S.a_ready(cur);
    if constexpr (SP2) {
        PG8_STAGE(PG8_SB(0, 0), cB, voffB); PG8_STAGE(PG8_SB(0, 1), cB + hstep, voffB); PG8_STAGE(PG8_SA(0, 0), cA, voffA); PG8_STAGE(PG8_SA(0, 1), cA + hstep, voffA);
        if (wr == 1) PG8_BAR;
        PG8_WAIT_V(2); PG8_BAR;
        PG8_STAGE(PG8_SB(1, 0), cB + kstep, voffB); PG8_STAGE(PG8_SA(1, 0), cA + kstep, voffA); PG8_STAGE(PG8_SB(1, 1), cB + hstep + kstep, voffB);
        PG8_WAIT_V(6); PG8_BAR;
    } else {
        PG8_STAGE(PG8_SB(0, 0), cB, voffB); PG8_STAGE(PG8_SA(0, 0), cA, voffA); PG8_STAGE(PG8_SB(0, 1), cB + hstep, voffB); PG8_STAGE(PG8_SA(0, 1), cA + hstep, voffA);
        if (wr == 1) PG8_BAR;
        PG8_WAIT_V(4); PG8_BAR;
        PG8_STAGE(PG8_SB(1, 0), cB + kstep, voffB); PG8_STAGE(PG8_SA(1, 0), cA + kstep, voffA); PG8_STAGE(PG8_SB(1, 1), cB + hstep + kstep, voffB);
        PG8_WAIT_V(6); PG8_BAR;
    }
    for (;;) {
        const bool has_next = S.next(ui + 1, nxt);
        const char* nA = has_next ? (const char*)(nxt.sel ? g.A1 : g.A0) + (size_t)nxt.pm * tstep : cA; const char* nB = has_next ? (const char*)(nxt.sel ? g.B1 : g.B0) + (size_t)nxt.pn * tstep : cB;
        for (int t = 0; t < nt; t += 2) {
            const bool last = (t == nt - 2);
            const char* a1 = cA + (size_t)(t + 1) * kstep;
            const char* a2 = last ? nA : cA + (size_t)(t + 2) * kstep; const char* b2 = last ? nB : cB + (size_t)(t + 2) * kstep;
            const char* a3 = a2 + kstep; const char* b3 = b2 + kstep;
            if (last && has_next) S.a_ready(nxt);
            if constexpr (SP2) {
            PG8_LDB(B0, 0, 0); PG8_LDB(B1, 0, 1); PG8_SCHED; PG8_LDA(At, 0, 0); PG8_STAGE(PG8_SA(1, 1), a1 + hstep, voffA);
            PG8_WAIT_V(8); PG8_WAIT_L(0); PG8_BAR; PG8_MMA(0, 0, At, B0); PG8_MMA(0, 1, At, B1); PG8_BAR; PG8_SCHED;
            PG8_LDA(At, 0, 1); PG8_STAGE(PG8_SB(0, 0), b2, voffB); PG8_STAGE(PG8_SB(0, 1), b2 + hstep, voffB); PG8_STAGE(PG8_SA(0, 0), a2, voffA);
            PG8_WAIT_V(8); PG8_WAIT_L(0); PG8_BAR; PG8_MMA(1, 0, At, B0); PG8_MMA(1, 1, At, B1); PG8_BAR; PG8_SCHED;
            PG8_LDB(B0, 1, 0); PG8_LDB(B1, 1, 1); PG8_SCHED; PG8_LDA(At, 1, 0); PG8_STAGE(PG8_SA(0, 1), a2 + hstep, voffA);
            PG8_WAIT_V(8); PG8_WAIT_L(0); PG8_BAR; PG8_MMA(0, 0, At, B0); PG8_MMA(0, 1, At, B1); PG8_BAR; PG8_SCHED;
            PG8_LDA(At, 1, 1); PG8_STAGE(PG8_SB(1, 0), b3, voffB); PG8_STAGE(PG8_SB(1, 1), b3 + hstep, voffB); PG8_STAGE(PG8_SA(1, 0), a3, voffA);
            PG8_WAIT_V(8); PG8_WAIT_L(0); PG8_BAR; PG8_MMA(1, 0, At, B0); PG8_MMA(1, 1, At, B1); PG8_BAR; PG8_SCHED;
            } else {
            PG8_LDB(B0, 0, 0); PG8_SCHED; PG8_LDA(At, 0, 0); PG8_STAGE(PG8_SA(1, 1), a1 + hstep, voffA);
            PG8_WAIT_L(8); PG8_BAR; PG8_WAIT_L(0); PG8_MMA(0, 0, At, B0); PG8_BAR; PG8_SCHED;
            PG8_LDB(B1, 0, 1); PG8_STAGE(PG8_SB(0, 0), b2, voffB);
            PG8_BAR; PG8_WAIT_L(0); PG8_MMA(0, 1, At, B1); PG8_BAR;
            PG8_LDA(At, 0, 1); PG8_STAGE(PG8_SA(0, 0), a2, voffA);
            PG8_BAR; PG8_WAIT_L(0); PG8_MMA(1, 0, At, B0); PG8_BAR; PG8_SCHED;
            PG8_STAGE(PG8_SB(0, 1), b2 + hstep, voffB);
            PG8_WAIT_V(6); PG8_BAR; PG8_MMA(1, 1, At, B1); PG8_BAR;
            PG8_LDB(B0, 1, 0); PG8_SCHED; PG8_LDA(At, 1, 0); PG8_STAGE(PG8_SA(0, 1), a2 + hstep, voffA);
            PG8_WAIT_L(8); PG8_BAR; PG8_WAIT_L(0); PG8_MMA(0, 0, At, B0); PG8_BAR; PG8_SCHED;
            PG8_LDB(B1, 1, 1); PG8_STAGE(PG8_SB(1, 0), b3, voffB);
            PG8_BAR; PG8_WAIT_L(0); PG8_MMA(0, 1, At, B1); PG8_BAR;
            PG8_LDA(At, 1, 1); PG8_STAGE(PG8_SA(1, 0), a3, voffA);
            PG8_BAR; PG8_WAIT_L(0); PG8_MMA(1, 0, At, B0); PG8_BAR; PG8_SCHED;
            PG8_STAGE(PG8_SB(1, 1), b3 + hstep, voffB);
            PG8_WAIT_V(6); PG8_BAR; PG8_MMA(1, 1, At, B1); PG8_BAR;
            }
        }
        if constexpr (ALIGN_EPI) { if (wr == 0) PG8_BAR; }
        if constexpr (!Epi::AFTER_DRAIN) { E(acc, cur, wr, wc, fr, fq); S.done(cur); }
        if (!has_next) break;
        if (!E.keep(cur)) {
#pragma unroll
        for (int a = 0; a < 2; ++a)
#pragma unroll
            for (int b = 0; b < 2; ++b)
#pragma unroll
                for (int m = 0; m < 4; ++m)
#pragma unroll
                    for (int n = 0; n < 2; ++n) acc[a][b][m][n] = (f32x4){0.f, 0.f, 0.f, 0.f};
        }
        cur = nxt; cA = nA; cB = nB; ++ui;
        if constexpr (ALIGN_EPI) { if (wr == 1) PG8_BAR; }
    }
    PG8_WAIT_V(0);
    if constexpr (!ALIGN_EPI) { if (wr == 0) PG8_BAR; }
    PG8_BAR;
    if constexpr (Epi::AFTER_DRAIN) { E.fused(acc, cur, wr, wc, fr, fq, lds, wid, lane); S.done(cur); }
#undef PG8_SA
#undef PG8_SB
#undef PG8_STAGE
#undef PG8_LDA
#undef PG8_LDB
#undef PG8_MMA
#undef PG8_WAIT_V
#undef PG8_WAIT_L
#undef PG8_BAR
#undef PG8_SCHED
}
}

#define GAS __attribute__((address_space(1)))
#define LAS __attribute__((address_space(3)))
typedef unsigned short bf16;
typedef unsigned v4u __attribute__((ext_vector_type(4)));
typedef float f32x4 __attribute__((ext_vector_type(4)));
typedef short bf16x8 __attribute__((ext_vector_type(8)));
typedef GAS unsigned gu32;
typedef GAS unsigned long long gu64;
#define RLX_AGENT __ATOMIC_RELAXED, __HIP_MEMORY_SCOPE_AGENT
#define LDS_WAIT() asm volatile("s_waitcnt lgkmcnt(0)" ::: "memory")
#define VM_WAIT() asm volatile("s_waitcnt vmcnt(0)" ::: "memory")
__device__ __forceinline__ unsigned long long rt() { return __builtin_amdgcn_s_memrealtime(); }
__device__ __forceinline__ unsigned f2bf(float f) { unsigned u = __builtin_bit_cast(unsigned, f); return (u + 0x7fffu + ((u >> 16) & 1u)) >> 16; }
__device__ __forceinline__ unsigned pk2(float lo, float hi) { return f2bf(lo) | (f2bf(hi) << 16); }

#define XB_TMO      128
#define XB_XCNT(j)  (256  + 64 * (j))
#define XB_XSUB(j)  (1280 + 64 * (j))
#define XB_XGEN(j)  (2304 + 64 * (j))
#define XB_TOP      3328
#define XB_TOPGEN   3392
#define XCD_BAR_WORDS 3456
#define XB_SPIN_CAP (1u << 18)

__device__ __forceinline__ unsigned xb_ld(unsigned* p)              { return __hip_atomic_load(p, __ATOMIC_RELAXED, __HIP_MEMORY_SCOPE_AGENT); }
__device__ __forceinline__ unsigned xb_add(unsigned* p, unsigned v) { return __hip_atomic_fetch_add(p, v, __ATOMIC_RELAXED, __HIP_MEMORY_SCOPE_AGENT); }
__device__ __forceinline__ unsigned xb_xcc_id() { return (unsigned)__builtin_amdgcn_s_getreg((3 << 11) | 20) & 0xFu; }
#define XB_SPIN(cond, bar) do { unsigned _sp = 0; while (cond) { __builtin_amdgcn_s_sleep(1); \
    if ((++_sp & 255u) == 0u) { if (xb_ld(&(bar)[XB_TMO])) break; if (_sp > XB_SPIN_CAP) { atomicAdd(&(bar)[XB_TMO], 1u); break; } } } } while (0)

struct XcdBarrier {
    unsigned* bar; unsigned x;
    volatile LAS unsigned* st;
};

__device__ __forceinline__ XcdBarrier xcd_barrier_post(unsigned* bar, volatile LAS unsigned* st) {
    XcdBarrier b; b.bar = bar; b.x = xb_xcc_id(); b.st = st;
    if (threadIdx.x == 0) (void)xb_add(&bar[XB_XCNT(b.x)], 1u);
    return b;
}
__device__ __forceinline__ void xcd_barrier_complete(unsigned* bar, unsigned x, unsigned& nloc, unsigned& nx) {
    const unsigned G = gridDim.x * gridDim.y * gridDim.z;
    unsigned sum, cnt, mine, sp = 0u;
    for (;;) {
        sum = 0u; cnt = 0u; mine = 0u;
#pragma unroll
        for (unsigned j = 0; j < 16; ++j) { const unsigned c = xb_ld(&bar[XB_XCNT(j)]); sum += c; cnt += (c > 0u) ? 1u : 0u; mine = (j == x) ? c : mine; }
        if (sum == G) break;
        __builtin_amdgcn_s_sleep(1);
        if ((++sp & 255u) == 0u) { if (xb_ld(&bar[XB_TMO])) break; if (sp > XB_SPIN_CAP) { atomicAdd(&bar[XB_TMO], 1u); break; } }
    }
    nloc = mine > 0u ? mine : 1u; nx = cnt > 0u ? cnt : 1u;
}

__device__ __forceinline__ void xcd_barrier(const XcdBarrier& b) {
    asm volatile("s_waitcnt vmcnt(0)" ::: "memory");
    __syncthreads();
    if (threadIdx.x == 0) {
        unsigned* bar = b.bar;
        __builtin_amdgcn_s_waitcnt(0);
        unsigned nloc = b.st[0], nx = b.st[1];
        if (nloc == 0u) { xcd_barrier_complete(bar, b.x, nloc, nx); b.st[0] = nloc; b.st[1] = nx; }
        const unsigned old = xb_add(&bar[XB_XSUB(b.x)], 1u);
        const unsigned gen = old / nloc;
        if (old + 1u == (gen + 1u) * nloc) {
            __builtin_amdgcn_fence(__ATOMIC_RELEASE, "agent");
            asm volatile("s_waitcnt vmcnt(0)" ::: "memory");
            const unsigned og = xb_add(&bar[XB_TOP], 1u);
            const unsigned tg = og / nx;
            if (og + 1u == (tg + 1u) * nx) xb_add(&bar[XB_TOPGEN], 1u);
            else XB_SPIN(xb_ld(&bar[XB_TOPGEN]) == tg, bar);
            __builtin_amdgcn_fence(__ATOMIC_ACQUIRE, "agent");
            xb_add(&bar[XB_XGEN(b.x)], 1u);
            asm volatile("s_waitcnt vmcnt(0)" ::: "memory");
        } else {
            XB_SPIN(xb_ld(&bar[XB_XGEN(b.x)]) == gen, bar);
            __builtin_amdgcn_fence(__ATOMIC_ACQUIRE, "agent");
            asm volatile("s_waitcnt vmcnt(0)" ::: "memory");
        }
    }
    __syncthreads();
}

typedef float f32x16 __attribute__((ext_vector_type(16)));
typedef float f32x2_t __attribute__((ext_vector_type(2)));
typedef __bf16 bf16x2_t __attribute__((ext_vector_type(2)));
typedef unsigned u32x2 __attribute__((ext_vector_type(2)));
__device__ __forceinline__ unsigned cvtpk(float lo, float hi) { f32x2_t v = {lo, hi}; bf16x2_t b = __builtin_convertvector(v, bf16x2_t); return __builtin_bit_cast(unsigned, b); }
__device__ __forceinline__ v4u pack8(f32x4 a, f32x4 b) { v4u w; w.x = cvtpk(a[0], a[1]); w.y = cvtpk(a[2], a[3]); w.z = cvtpk(b[0], b[1]); w.w = cvtpk(b[2], b[3]); return w; }
__device__ __forceinline__ unsigned short bf1(float v) { return (unsigned short)(cvtpk(v, 0.f) & 0xffffu); }
__device__ __forceinline__ float bf2f(unsigned short b) { return __uint_as_float(((unsigned)b) << 16); }
__device__ __forceinline__ float sigmoidf_(float v) { return __builtin_amdgcn_rcpf(1.0f + __expf(-v)); }
__device__ __forceinline__ int crow(int r, int hi) { return (r & 3) + 8 * (r >> 2) + 4 * hi; }
__device__ __forceinline__ void sincos_turns(float ang, float& s, float& c) {
    double r = (double)ang * 0.15915494309189535; r = r - __builtin_rint(r); const float f = (float)r;
    s = __builtin_amdgcn_sinf(f); c = __builtin_amdgcn_cosf(f);
}
__device__ __forceinline__ float log2_gamma(int h) { return __log2f(1.0f - exp2f(-5.0f - (float)h)); }

using pg8::Unit; using pg8::bf16_t;
__host__ __device__ __forceinline__ int win_src_col(int nv) {
    if (nv < 1280) return nv;
    if (nv < 2304) { const int r = nv - 1280, sec = r >> 9, hh = (r >> 7) & 3, p = r & 127, a = p >> 5, b = (p >> 3) & 3, n = (p >> 2) & 1, j = p & 3;
        return 1304 + sec * 512 + hh * 128 + 64 * n + 16 * a + 4 * b + j; }
    if (nv < 5376) return nv + 24;
    if (nv < 5400) return 1280 + (nv - 5376);
    return -1;
}
struct Epi1 {
    static constexpr bool PERM = true, AFTER_DRAIN = false;
    unsigned char* ws; const int* pos;
    __device__ __forceinline__ bool keep(const Unit&) const { return false; }
    __device__ __forceinline__ void operator()(f32x4 (&acc)[2][2][4][2], const Unit& u, int wr, int wc, int fr, int fq) const {
        const int pn = u.pn; int rowb = u.pm * 256 + wr * 64 + fr, cl = wc * 32 + 8 * fq;
        asm volatile("" : "+v"(rowb), "+v"(cl));
        const float* rstd = (const float*)(ws + WS_RSTD1);
        if (EPI1_EN(0) && pn < 5) {
            const bool rotw = (wc & 1) == 0;
#pragma unroll
            for (int ai = 0; ai < 2; ++ai)
#pragma unroll
                for (int m = 0; m < 4; ++m) {
                    const int row = rowb + ai * 128 + m * 16; const float rs = rstd[row];
                    const float p = rotw ? (float)pos[row] : 0.f;
#pragma unroll
                    for (int bj = 0; bj < 2; ++bj) {
                        f32x4 v0 = acc[ai][bj][m][0] * rs, v1 = acc[ai][bj][m][1] * rs;
                        const bool isk = (pn < 2) || (bj == 0);
                        if (rotw && isk) {
#pragma unroll
                            for (int j = 0; j < 4; ++j) {
                                float t0 = -13.122363377404328f * (float)j; t0 = t0 * 2.0f; t0 = t0 / 16.0f;
                                float t1 = -13.122363377404328f * (float)(4 + j); t1 = t1 * 2.0f; t1 = t1 / 16.0f;
                                float s0, c0, s1, c1; sincos_turns(p * expf(t0), s0, c0); sincos_turns(p * expf(t1), s1, c1);
                                const float q0 = __shfl_xor(v0[j], 16), q1 = __shfl_xor(v1[j], 16);
                                if (fq == 0) { v0[j] = v0[j] * c0 - q0 * s0; v1[j] = v1[j] * c1 - q1 * s1; }
                                else if (fq == 1) { v0[j] = q0 * s0 + v0[j] * c0; v1[j] = q1 * s1 + v1[j] * c1; }
                            }
                        }
                        if (pn < 2) { v0 = v0 * QSCALE; v1 = v1 * QSCALE;
                            *(v4u*)((bf16_t*)(ws + WS_Q) + (size_t)row * 512 + pn * 256 + bj * 128 + cl) = pack8(v0, v1);
                        } else if (bj == 0) {
                            bf16_t* dst = (bf16_t*)(ws + (pn == 2 ? WS_KC : pn == 3 ? WS_KS : WS_KW));
                            *(v4u*)(dst + (size_t)row * 128 + cl) = pack8(v0, v1);
                        } else if (pn == 2) {
                            *(v4u*)((bf16_t*)(ws + WS_VC) + (size_t)row * 128 + cl) = pack8(v0, v1);
                        } else {
                            bf16_t* dst = (bf16_t*)(ws + (pn == 3 ? WS_VST : WS_VWT)) + (size_t)cl * S + row;
#pragma unroll
                            for (int j = 0; j < 4; ++j) { dst[(size_t)j * S] = bf1(v0[j]); dst[(size_t)(4 + j) * S] = bf1(v1[j]); }
                        }
                    }
                }
        } else if (EPI1_EN(1) && pn < 9) {
            const bool isk = pn >= 7;
#pragma unroll
            for (int ai = 0; ai < 2; ++ai)
#pragma unroll
                for (int m = 0; m < 4; ++m) {
                    const int row = rowb + ai * 128 + m * 16; const float rs = rstd[row]; const float p = (float)pos[row];
#pragma unroll
                    for (int bj = 0; bj < 2; ++bj) {
                        const int hh = ((pn - 5) & 1) * 2 + bj;
                        const f32x4 x1 = acc[ai][bj][m][0] * rs, x2 = acc[ai][bj][m][1] * rs; f32x4 o1, o2;
#pragma unroll
                        for (int j = 0; j < 4; ++j) {
                            float t = -9.210340371976184f * (float)(16 * wc + 4 * fq + j); t = t * 2.0f; t = t / 128.0f;
                            float sn, cs; sincos_turns(p * expf(t), sn, cs);
                            o1[j] = x1[j] * cs - x2[j] * sn; o2[j] = x1[j] * sn + x2[j] * cs; }
                        if (isk) { o1 = o1 * KSC_RET; o2 = o2 * KSC_RET; }
                        *(v4u*)((bf16_t*)(ws + (isk ? WS_RK : WS_RQ)) + (size_t)row * 512 + hh * 128 + cl) = pack8(o1, o2);
                        if (isk) {
                            const float zeta = exp2f((float)(127 - (row & 127)) * log2_gamma(hh));
                            bf16_t* dst = (bf16_t*)(ws + WS_RKT) + (size_t)(hh * 128 + cl) * S + row;
#pragma unroll
                            for (int j = 0; j < 4; ++j) { dst[(size_t)j * S] = bf1(o1[j] * zeta); dst[(size_t)(4 + j) * S] = bf1(o2[j] * zeta); }
                        }
                    }
                }
        } else if (EPI1_EN(2) && pn < 11) {
#pragma unroll
            for (int ai = 0; ai < 2; ++ai)
#pragma unroll
                for (int m = 0; m < 4; ++m) {
                    const int row = rowb + ai * 128 + m * 16; const float rs = rstd[row];
#pragma unroll
                    for (int bj = 0; bj < 2; ++bj) {
                        const int hh = (pn - 9) * 2 + bj; const f32x4 v0 = acc[ai][bj][m][0] * rs, v1 = acc[ai][bj][m][1] * rs;
                        bf16_t* dst = (bf16_t*)(ws + WS_RVT) + (size_t)(hh * 128 + cl) * S + row;
#pragma unroll
                        for (int j = 0; j < 4; ++j) { dst[(size_t)j * S] = bf1(v0[j]); dst[(size_t)(4 + j) * S] = bf1(v1[j]); }
                    }
                }
        } else if (EPI1_EN(3) && pn < 21) {
#pragma unroll
            for (int ai = 0; ai < 2; ++ai)
#pragma unroll
                for (int m = 0; m < 4; ++m) {
                    const int row = rowb + ai * 128 + m * 16; const float rs = rstd[row];
#pragma unroll
                    for (int bj = 0; bj < 2; ++bj) {
                        f32x4 v0 = acc[ai][bj][m][0] * rs, v1 = acc[ai][bj][m][1] * rs;
#pragma unroll
                        for (int j = 0; j < 4; ++j) { const float s0 = sigmoidf_(v0[j]), s1 = sigmoidf_(v1[j]); v0[j] = pn < 13 ? v0[j] * s0 : s0; v1[j] = pn < 13 ? v1[j] * s1 : s1; }
                        bf16_t* dst;
                        if (pn < 13) dst = (bf16_t*)(ws + WS_RG) + (size_t)row * 512 + (pn - 11) * 256;
                        else if (pn < 17) dst = (bf16_t*)(ws + WS_SGA) + (size_t)row * 1024 + (pn - 13) * 256;
                        else dst = (bf16_t*)(ws + WS_SGB) + (size_t)row * 1024 + (pn - 17) * 256;
                        *(v4u*)(dst + bj * 128 + cl) = pack8(v0, v1);
                    }
                }
        } else {
            if (EPI1_EN(4) && wc == 0) {
#pragma unroll
                for (int ai = 0; ai < 2; ++ai)
#pragma unroll
                    for (int m = 0; m < 4; ++m) {
                        const int row = rowb + ai * 128 + m * 16; const float rs = rstd[row];
                        f32x4 v0 = acc[ai][0][m][0] * rs, v1 = acc[ai][0][m][1] * rs;
#pragma unroll
                        for (int j = 0; j < 4; ++j) { v0[j] = sigmoidf_(v0[j]); v1[j] = sigmoidf_(v1[j]); }
                        float* dst = (float*)(ws + WS_GATES) + (size_t)row * 32 + cl;
                        *(f32x4*)dst = v0; *(f32x4*)(dst + 4) = v1;
                    }
            }
        }
    }
};
struct EpiMix {
    static constexpr bool PERM = true, AFTER_DRAIN = false;
    unsigned char* ws;
    __device__ __forceinline__ bool keep(const Unit& u) const { return u.sel == 0; }
    __device__ __forceinline__ void operator()(f32x4 (&acc)[2][2][4][2], const Unit& u, int wr, int wc, int fr, int fq) const {
        const int rowb = u.pm * 256 + wr * 64 + fr, colb = u.pn * 256 + wc * 32 + 8 * fq;
        const bool first = u.sel == 0;
#pragma unroll
        for (int ai = 0; ai < 2; ++ai)
#pragma unroll
            for (int m = 0; m < 4; ++m) {
                const int row = rowb + ai * 128 + m * 16;
#pragma unroll
                for (int bj = 0; bj < 2; ++bj) {
                    const size_t off = (size_t)row * 1024 + colb + bj * 128;
                    const v4u gb = *(const v4u*)((const bf16_t*)(ws + WS_SGB) + off);
                    f32x4 b0, b1;
                    b0[0] = __uint_as_float(gb.x << 16); b0[1] = __uint_as_float(gb.x & 0xffff0000u); b0[2] = __uint_as_float(gb.y << 16); b0[3] = __uint_as_float(gb.y & 0xffff0000u);
                    b1[0] = __uint_as_float(gb.z << 16); b1[1] = __uint_as_float(gb.z & 0xffff0000u); b1[2] = __uint_as_float(gb.w << 16); b1[3] = __uint_as_float(gb.w & 0xffff0000u);
                    if (first) {
                        const v4u ga = *(const v4u*)((const bf16_t*)(ws + WS_SGA) + off);
                        f32x4 a0, a1;
                        a0[0] = __uint_as_float(ga.x << 16); a0[1] = __uint_as_float(ga.x & 0xffff0000u); a0[2] = __uint_as_float(ga.y << 16); a0[3] = __uint_as_float(ga.y & 0xffff0000u);
                        a1[0] = __uint_as_float(ga.z << 16); a1[1] = __uint_as_float(ga.z & 0xffff0000u); a1[2] = __uint_as_float(ga.w << 16); a1[3] = __uint_as_float(ga.w & 0xffff0000u);
#pragma unroll
                        for (int j = 0; j < 4; ++j) { a0[j] = a0[j] * __builtin_amdgcn_rcpf(b0[j]); a1[j] = a1[j] * __builtin_amdgcn_rcpf(b1[j]); }
                        acc[ai][bj][m][0] = acc[ai][bj][m][0] * a0; acc[ai][bj][m][1] = acc[ai][bj][m][1] * a1;
                    } else {
                        *(v4u*)((bf16_t*)(ws + WS_MIX) + off) = pack8(acc[ai][bj][m][0] * b0, acc[ai][bj][m][1] * b1);
                    }
                }
            }
    }
};
template <bool WRITE_BF16> struct EpiRes {
    static constexpr bool PERM = true, AFTER_DRAIN = false;
    const float* base; float* out; bf16_t* outb; float* ssq;
    __device__ __forceinline__ bool keep(const Unit&) const { return false; }
    __device__ __forceinline__ void operator()(f32x4 (&acc)[2][2][4][2], const Unit& u, int wr, int wc, int fr, int fq) const {
        const int rowb = u.pm * 256 + wr * 64 + fr, colb = u.pn * 256 + wc * 32 + 8 * fq;
#pragma unroll
        for (int ai = 0; ai < 2; ++ai)
#pragma unroll
            for (int m = 0; m < 4; ++m) {
                const int row = rowb + ai * 128 + m * 16; float ss = 0.f;
#pragma unroll
                for (int bj = 0; bj < 2; ++bj) {
                    const size_t off = (size_t)row * 1024 + colb + bj * 128;
                    const f32x4 b0 = *(const f32x4*)(base + off), b1 = *(const f32x4*)(base + off + 4);
                    const f32x4 v0 = acc[ai][bj][m][0] + b0, v1 = acc[ai][bj][m][1] + b1;
                    *(f32x4*)(out + off) = v0; *(f32x4*)(out + off + 4) = v1;
                    if (WRITE_BF16) *(v4u*)(outb + off) = pack8(v0, v1);
                    ss += (v0[0] * v0[0] + v0[1] * v0[1]) + (v0[2] * v0[2] + v0[3] * v0[3]) + (v1[0] * v1[0] + v1[1] * v1[1]) + (v1[2] * v1[2] + v1[3] * v1[3]);
                }
                ss += __shfl_xor(ss, 16); ss += __shfl_xor(ss, 32);
                if (fq == 0) atomicAdd(ssq + row, ss);
            }
    }
};
struct EpiUp {
    static constexpr bool PERM = true, AFTER_DRAIN = false;
    const float* ssq; bf16_t* O;
    __device__ __forceinline__ bool keep(const Unit&) const { return false; }
    __device__ __forceinline__ void operator()(f32x4 (&acc)[2][2][4][2], const Unit& u, int wr, int wc, int fr, int fq) const {
        const int rowb = u.pm * 256 + wr * 64 + fr, colb = u.pn * 256 + wc * 32 + 8 * fq;
#pragma unroll
        for (int ai = 0; ai < 2; ++ai)
#pragma unroll
            for (int m = 0; m < 4; ++m) {
                const int row = rowb + ai * 128 + m * 16; const float rs = __builtin_amdgcn_rsqf(ssq[row] * (1.0f / D) + NORM_EPS);
#pragma unroll
                for (int bj = 0; bj < 2; ++bj) {
                    f32x4 v0 = acc[ai][bj][m][0] * rs, v1 = acc[ai][bj][m][1] * rs;
#pragma unroll
                    for (int j = 0; j < 4; ++j) { const float a = fmaxf(v0[j], 0.f), b = fmaxf(v1[j], 0.f); v0[j] = a * a; v1[j] = b * b; }
                    *(v4u*)(O + (size_t)row * FF + colb + bj * 128) = pack8(v0, v1);
                }
            }
    }
};

struct Frame {
    LAS unsigned char* lds;
    volatile LAS unsigned* MISC;
    gu32* ctl;
    int tid, lane, wave;
    int vcu, G;
    unsigned char* ws; unsigned char* dout;
};
__device__ __forceinline__ float wave_sum(float v) {
#pragma unroll
    for (int o = 1; o < 64; o <<= 1) v += __shfl_xor(v, o);
    return v;
}
__device__ __forceinline__ void p0_transpose_item(const float* W, int ldw, int K, bf16* WT, int n0, int k0, int srccol, const float* kscale, LAS float* scr, int lane) {
#pragma unroll 8
    for (int i = 0; i < 32; ++i) { const int kk = 2 * i + (lane >> 5); float v = 0.f;
        if (srccol >= 0) { v = W[(size_t)(k0 + kk) * ldw + srccol]; if (kscale) v *= kscale[k0 + kk]; }
        scr[kk * 33 + (lane & 31)] = v; }
    LDS_WAIT(); asm volatile("" ::: "memory");
    const int c = lane & 7;
#pragma unroll
    for (int j = 0; j < 4; ++j) { const int n = (lane >> 3) + 8 * j; const LAS float* s = scr + (8 * c) * 33 + n;
        v4u o; o.x = cvtpk(s[0 * 33], s[1 * 33]); o.y = cvtpk(s[2 * 33], s[3 * 33]); o.z = cvtpk(s[4 * 33], s[5 * 33]); o.w = cvtpk(s[6 * 33], s[7 * 33]);
        *(GAS v4u*)(WT + (size_t)(n0 + n) * K + k0 + 8 * c) = o; }
    LDS_WAIT(); asm volatile("" ::: "memory");
}
struct Args { const void* in[17]; float* out; unsigned char* ws; };

__device__ __forceinline__ void p0_prologue(Frame& F, const Args& a) {
    LAS float* scr = (LAS float*)(F.lds + F.wave * 16384);
    const int gw = F.vcu * 8 + F.wave, NGW = F.G * 8, lane = F.lane;
    constexpr int I_WIN = 16 * (NVIRT / 32), I_PA = 8 * 32, I_PB = 8 * 32, I_OUT = 16 * 32, I_UP = 16 * 128, I_DN = 64 * 32, I_W1 = 32 * 8, I_W2 = 4 * 2;
    constexpr int NITEMS = I_WIN + I_PA + I_PB + I_OUT + I_UP + I_DN + 2 * I_W1 + 2 * I_W2;
    for (int it = gw; it < NITEMS; it += NGW) {
        int r = it;
        if (r < I_WIN) { const int nb = r % (NVIRT / 32), kb = r / (NVIRT / 32); p0_transpose_item((const float*)a.in[3], INW, 1024, (bf16*)(F.ws + WS_WIN), nb * 32, kb * 64, win_src_col(nb * 32 + (lane & 31)), (const float*)a.in[2], scr, lane); continue; } r -= I_WIN;
        if (r < I_PA) { const int nb = r % 32, kb = r / 32; p0_transpose_item((const float*)a.in[10], 1024, 512, (bf16*)(F.ws + WS_WPA), nb * 32, kb * 64, nb * 32 + (lane & 31), nullptr, scr, lane); continue; } r -= I_PA;
        if (r < I_PB) { const int nb = r % 32, kb = r / 32; p0_transpose_item((const float*)a.in[11], 1024, 512, (bf16*)(F.ws + WS_WPB), nb * 32, kb * 64, nb * 32 + (lane & 31), nullptr, scr, lane); continue; } r -= I_PB;
        if (r < I_OUT) { const int nb = r % 32, kb = r / 32; p0_transpose_item((const float*)a.in[12], 1024, 1024, (bf16*)(F.ws + WS_WOUT), nb * 32, kb * 64, nb * 32 + (lane & 31), nullptr, scr, lane); continue; } r -= I_OUT;
        if (r < I_UP) { const int nb = r % 128, kb = r / 128; p0_transpose_item((const float*)a.in[14], 4096, 1024, (bf16*)(F.ws + WS_WUP), nb * 32, kb * 64, nb * 32 + (lane & 31), (const float*)a.in[13], scr, lane); continue; } r -= I_UP;
        if (r < I_DN) { const int nb = r % 32, kb = r / 32; p0_transpose_item((const float*)a.in[15], 1024, 4096, (bf16*)(F.ws + WS_WDN), nb * 32, kb * 64, nb * 32 + (lane & 31), nullptr, scr, lane); continue; } r -= I_DN;
        if (r < I_W1) { const int nb = r % 8, kb = r / 8; p0_transpose_item((const float*)a.in[6], 256, 2048, (bf16*)(F.ws + WS_W1K), nb * 32, kb * 64, nb * 32 + (lane & 31), nullptr, scr, lane); continue; } r -= I_W1;
        if (r < I_W1) { const int nb = r % 8, kb = r / 8; p0_transpose_item((const float*)a.in[8], 256, 2048, (bf16*)(F.ws + WS_W1V), nb * 32, kb * 64, nb * 32 + (lane & 31), nullptr, scr, lane); continue; } r -= I_W1;
        if (r < I_W2) { const int nb = r % 2, kb = r / 2; p0_transpose_item((const float*)a.in[7], 64, 256, (bf16*)(F.ws + WS_W2K), nb * 32, kb * 64, nb * 32 + (lane & 31), nullptr, scr, lane); continue; } r -= I_W2;
        { const int nb = r % 2, kb = r / 2; p0_transpose_item((const float*)a.in[9], 64, 256, (bf16*)(F.ws + WS_W2V), nb * 32, kb * 64, nb * 32 + (lane & 31), nullptr, scr, lane); }
    }
    const float* x = (const float*)a.in[0]; bf16* xb = (bf16*)(F.ws + WS_XB); float* rstd = (float*)(F.ws + WS_RSTD1);
    for (int m = gw; m < S; m += NGW) {
        const GAS f32x4* xr = (const GAS f32x4*)(x + (size_t)m * D) + lane;
        f32x4 v[4]; float s = 0.f;
#pragma unroll
        for (int j = 0; j < 4; ++j) { v[j] = xr[64 * j]; s += (v[j].x * v[j].x + v[j].y * v[j].y) + (v[j].z * v[j].z + v[j].w * v[j].w); }
        s = wave_sum(s);
        GAS unsigned long long* o8 = (GAS unsigned long long*)(xb + (size_t)m * D) + lane;
#pragma unroll
        for (int j = 0; j < 4; ++j) o8[64 * j] = (unsigned long long)cvtpk(v[j].x, v[j].y) | ((unsigned long long)cvtpk(v[j].z, v[j].w) << 32);
        if (lane == 0) rstd[m] = 1.0f / sqrtf(s * (1.0f / D) + NORM_EPS);
    }
}

__device__ __forceinline__ void p2_compress_item(Frame& F, const Args& a, int item) {
    const int kind = item >> 6, tile = item & 63, lane = F.lane, w = F.wave, l31 = lane & 31, hi = lane >> 5;
    const int R = 32 * tile + l31, g = R >> 10, c = R & 1023, cc = c < 1023 ? c : 1022;
    const bf16* src = (const bf16*)(F.ws + (kind ? WS_VC : WS_KC)) + (size_t)(16 * cc) * 128 + g * 64 + 8 * hi;
    const float* pe = (const float*)a.in[kind ? 5 : 4] + 8 * hi;
    const bf16* w1t = (const bf16*)(F.ws + (kind ? WS_W1V : WS_W1K)) + (size_t)(32 * w + l31) * 2048 + 8 * hi;
    f32x16 acc = {};
#pragma unroll 4
    for (int ks = 0; ks < 128; ++ks) {
        const int l = ks >> 2, d = 16 * (ks & 3);
        const bf16x8 af = *(const bf16x8*)(w1t + 16 * ks);
        const v4u braw = *(const v4u*)(src + (size_t)l * 128 + d);
        const f32x4 pe0 = *(const f32x4*)(pe + l * 64 + d), pe1 = *(const f32x4*)(pe + l * 64 + d + 4);
        v4u bp;
        bp.x = cvtpk(__uint_as_float(braw.x << 16) + pe0[0], __uint_as_float(braw.x & 0xffff0000u) + pe0[1]);
        bp.y = cvtpk(__uint_as_float(braw.y << 16) + pe0[2], __uint_as_float(braw.y & 0xffff0000u) + pe0[3]);
        bp.z = cvtpk(__uint_as_float(braw.z << 16) + pe1[0], __uint_as_float(braw.z & 0xffff0000u) + pe1[1]);
        bp.w = cvtpk(__uint_as_float(braw.w << 16) + pe1[2], __uint_as_float(braw.w & 0xffff0000u) + pe1[3]);
        acc = __builtin_amdgcn_mfma_f32_32x32x16_bf16(af, __builtin_bit_cast(bf16x8, bp), acc, 0, 0, 0);
    }
    LAS bf16* H = (LAS bf16*)F.lds;
#pragma unroll
    for (int q4 = 0; q4 < 4; ++q4) {
        float v[4];
#pragma unroll
        for (int j = 0; j < 4; ++j) { const float t = acc[4 * q4 + j]; v[j] = t * sigmoidf_(t); }
        u32x2 o; o.x = cvtpk(v[0], v[1]); o.y = cvtpk(v[2], v[3]);
        *(LAS u32x2*)(H + l31 * 264 + 32 * w + 8 * q4 + 4 * hi) = o;
    }
    __syncthreads();
    if (w < 2) {
        const bf16* w2t = (const bf16*)(F.ws + (kind ? WS_W2V : WS_W2K)) + (size_t)(32 * w + l31) * 256 + 8 * hi;
        f32x16 o2 = {};
#pragma unroll
        for (int ks = 0; ks < 16; ++ks) {
            const bf16x8 af = *(const bf16x8*)(w2t + 16 * ks);
            const bf16x8 bfr = *(const LAS bf16x8*)(H + l31 * 264 + 16 * ks + 8 * hi);
            o2 = __builtin_amdgcn_mfma_f32_32x32x16_bf16(af, bfr, o2, 0, 0, 0);
        }
        if (kind == 0) {
            bf16* dst = (bf16*)(F.ws + WS_KCMP) + (size_t)c * 128 + g * 64 + 32 * w + 4 * hi;
#pragma unroll
            for (int q4 = 0; q4 < 4; ++q4) { u32x2 o; o.x = cvtpk(o2[4 * q4], o2[4 * q4 + 1]); o.y = cvtpk(o2[4 * q4 + 2], o2[4 * q4 + 3]); if (c == 1023) { o.x = 0u; o.y = 0u; } *(u32x2*)(dst + 8 * q4) = o; }
        } else {
            bf16* dst = (bf16*)(F.ws + WS_VCMPT) + (size_t)(g * 64 + 32 * w + 4 * hi) * 1024 + c;
#pragma unroll
            for (int r = 0; r < 16; ++r) dst[(size_t)((r & 3) + 8 * (r >> 2)) * 1024] = c == 1023 ? (bf16)0 : bf1(o2[r]);
        }
    }
    __syncthreads();
}
__device__ __forceinline__ void p2_kv_item(Frame& F, int item) {
    const int c = item >> 2, h = item & 3, lane = F.lane, w = F.wave, l31 = lane & 31, hi = lane >> 5;
    const int mt = w >> 1;
    const bf16* vt = (const bf16*)(F.ws + WS_RVT) + (size_t)(h * 128 + 32 * mt + l31) * S + 128 * c + 8 * hi;
    float* kv = (float*)(F.ws + WS_XB) + (size_t)(c * 4 + h) * 16384;
#pragma unroll
    for (int t2 = 0; t2 < 2; ++t2) {
        const int nt = 2 * (w & 1) + t2;
        const bf16* kt = (const bf16*)(F.ws + WS_RKT) + (size_t)(h * 128 + 32 * nt + l31) * S + 128 * c + 8 * hi;
        f32x16 acc = {};
#pragma unroll
        for (int ks = 0; ks < 8; ++ks) acc = __builtin_amdgcn_mfma_f32_32x32x16_bf16(*(const bf16x8*)(vt + 16 * ks), *(const bf16x8*)(kt + 16 * ks), acc, 0, 0, 0);
#pragma unroll
        for (int r = 0; r < 16; ++r) kv[(size_t)(32 * mt + crow(r, hi)) * 128 + 32 * nt + l31] = acc[r];
    }
}
__device__ __forceinline__ void p3_scan(Frame& F) {
    const int gt = (F.vcu * 8 + F.wave) * 64 + F.lane, NT = F.G * 512;
    const float* kv = (const float*)(F.ws + WS_XB); bf16* st = (bf16*)(F.dout + DO_ST);
    for (int i = gt; i < 65536; i += NT) {
        const int h = i >> 14; const float dec = exp2f(128.0f * log2_gamma(h));
        float s = 0.f;
        for (int c0 = 0; c0 < 128; c0 += 16) {
            float t[16];
#pragma unroll
            for (int u = 0; u < 16; ++u) t[u] = kv[(size_t)(c0 + u) * 65536 + i];
#pragma unroll
            for (int u = 0; u < 16; ++u) { st[(size_t)(c0 + u) * 65536 + i] = bf1(s); s = dec * s + t[u]; }
        }
    }
}
__device__ __forceinline__ void p4_ret_item(Frame& F, int item, int wq) {
    const int c = item >> 2, h = item & 3, lane = F.lane, l31 = lane & 31, hi = lane >> 5;
    const int n = 32 * wq + l31; const size_t tok = (size_t)128 * c + n;
    const float lg = log2_gamma(h);
    bf16x8 qf[8];
    { const bf16* qp = (const bf16*)(F.ws + WS_RQ) + tok * 512 + h * 128 + 8 * hi;
#pragma unroll
      for (int ks = 0; ks < 8; ++ks) qf[ks] = *(const bf16x8*)(qp + 16 * ks); }
    f32x16 acc[4];
    { const bf16* sp = (const bf16*)(F.dout + DO_ST) + (size_t)(c * 4 + h) * 16384 + (size_t)l31 * 128 + 8 * hi;
#pragma unroll
      for (int mt = 0; mt < 4; ++mt) { f32x16 t = {};
#pragma unroll
          for (int ks = 0; ks < 8; ++ks) t = __builtin_amdgcn_mfma_f32_32x32x16_bf16(*(const bf16x8*)(sp + (size_t)mt * 4096 + 16 * ks), qf[ks], t, 0, 0, 0);
          acc[mt] = t; }
      const float xi = exp2f((float)(n + 1) * lg);
#pragma unroll
      for (int mt = 0; mt < 4; ++mt) acc[mt] = acc[mt] * xi; }
    for (int u = 0; u <= wq; ++u) {
        const bf16* kp = (const bf16*)(F.ws + WS_RK) + ((size_t)128 * c + 32 * u + l31) * 512 + h * 128 + 8 * hi;
        f32x16 p = {};
#pragma unroll
        for (int ks = 0; ks < 8; ++ks) p = __builtin_amdgcn_mfma_f32_32x32x16_bf16(*(const bf16x8*)(kp + 16 * ks), qf[ks], p, 0, 0, 0);
        unsigned pk[8];
#pragma unroll
        for (int r = 0; r < 16; r += 2) {
            const int m0 = 32 * u + crow(r, hi), m1 = m0 + 1;
            const float d0 = n >= m0 ? exp2f((float)(n - m0) * lg) : 0.f, d1 = n >= m1 ? exp2f((float)(n - m1) * lg) : 0.f;
            pk[r >> 1] = cvtpk(p[r] * d0, p[r + 1] * d1);
        }
        const bf16* vp = (const bf16*)(F.ws + WS_RVT) + (size_t)(h * 128 + l31) * S + (size_t)128 * c + 32 * u + 4 * hi;
#pragma unroll
        for (int s2 = 0; s2 < 2; ++s2) {
            v4u bw; bw.x = pk[4 * s2]; bw.y = pk[4 * s2 + 1]; bw.z = pk[4 * s2 + 2]; bw.w = pk[4 * s2 + 3];
#pragma unroll
            for (int mt = 0; mt < 4; ++mt) {
                const bf16* vv = vp + (size_t)(32 * mt) * S + 16 * s2;
                const u32x2 a0 = *(const u32x2*)vv, a1 = *(const u32x2*)(vv + 8);
                v4u aw; aw.x = a0.x; aw.y = a0.y; aw.z = a1.x; aw.w = a1.y;
                acc[mt] = __builtin_amdgcn_mfma_f32_32x32x16_bf16(__builtin_bit_cast(bf16x8, aw), __builtin_bit_cast(bf16x8, bw), acc[mt], 0, 0, 0);
            }
        }
    }
    float ss = 0.f;
#pragma unroll
    for (int mt = 0; mt < 4; ++mt)
#pragma unroll
        for (int r = 0; r < 16; ++r) ss += acc[mt][r] * acc[mt][r];
    ss += __shfl_xor(ss, 32);
    const float rn = 1.0f / sqrtf(ss * (1.0f / 128.0f) + NORM_EPS);
    const bf16* gp = (const bf16*)(F.ws + WS_RG) + tok * 512 + h * 128 + 4 * hi;
    bf16* op = (bf16*)(F.dout + DO_RET) + tok * 512 + h * 128 + 4 * hi;
#pragma unroll
    for (int mt = 0; mt < 4; ++mt)
#pragma unroll
        for (int q4 = 0; q4 < 4; ++q4) {
            const u32x2 gr = *(const u32x2*)(gp + 32 * mt + 8 * q4);
            u32x2 o;
            o.x = cvtpk(acc[mt][4 * q4] * rn * __uint_as_float(gr.x << 16), acc[mt][4 * q4 + 1] * rn * __uint_as_float(gr.x & 0xffff0000u));
            o.y = cvtpk(acc[mt][4 * q4 + 2] * rn * __uint_as_float(gr.y << 16), acc[mt][4 * q4 + 3] * rn * __uint_as_float(gr.y & 0xffff0000u));
            *(u32x2*)(op + 32 * mt + 8 * q4) = o;
        }
}

template <int MODE>
__device__ __forceinline__ bool nsa_valid(int idx, int t, bool colsel) {
    if (MODE == 0) return 16 * idx + 31 <= t;
    if (MODE == 1) return idx <= t && idx > t - 512;
    return colsel && idx <= t;
}
__device__ __forceinline__ f32x16 nsa_qk(const bf16* krow, const bf16x8 (&qf)[4]) {
    f32x16 s = {};
#pragma unroll
    for (int ks = 0; ks < 4; ++ks) s = __builtin_amdgcn_mfma_f32_32x32x16_bf16(*(const bf16x8*)(krow + 16 * ks), qf[ks], s, 0, 0, 0);
    return s;
}
template <int MODE> __device__ __forceinline__ void nsa_stats(const f32x16& s, int keybase, int t, bool colsel, int hi, float& m, float& l) {
    float tm = NEGF;
#pragma unroll
    for (int r = 0; r < 16; ++r) { const bool v = nsa_valid<MODE>(keybase + crow(r, hi), t, colsel); tm = fmaxf(tm, v ? s[r] : NEGF); }
    const float mn = fmaxf(m, tm); float acc = l * exp2f(m - mn);
#pragma unroll
    for (int r = 0; r < 16; ++r) { const bool v = nsa_valid<MODE>(keybase + crow(r, hi), t, colsel); acc += v ? exp2f(s[r] - mn) : 0.f; }
    m = mn; l = acc;
}
__device__ __forceinline__ void nsa_merge_halves(float& m, float& l) {
    const float m2 = __shfl_xor(m, 32), l2 = __shfl_xor(l, 32), M = fmaxf(m, m2);
    const float L = l * exp2f(m - M) + l2 * exp2f(m2 - M);
    m = M; l = L > 0.f ? 1.0f / L : 0.f;
}
template <int MODE> __device__ __forceinline__ void nsa_probs(const f32x16& s, int keybase, int t, bool colsel, int hi, float M, float invl, float (&p)[16]) {
#pragma unroll
    for (int r = 0; r < 16; ++r) { const bool v = nsa_valid<MODE>(keybase + crow(r, hi), t, colsel); p[r] = v ? exp2f(s[r] - M) * invl : 0.f; }
}
__device__ __forceinline__ void nsa_pv(f32x16 (&o)[2], const bf16* vt, size_t ldv, const float (&p)[16], float gate) {
#pragma unroll
    for (int s2 = 0; s2 < 2; ++s2) {
        v4u bw; bw.x = cvtpk(p[8 * s2] * gate, p[8 * s2 + 1] * gate); bw.y = cvtpk(p[8 * s2 + 2] * gate, p[8 * s2 + 3] * gate);
        bw.z = cvtpk(p[8 * s2 + 4] * gate, p[8 * s2 + 5] * gate); bw.w = cvtpk(p[8 * s2 + 6] * gate, p[8 * s2 + 7] * gate);
#pragma unroll
        for (int mt = 0; mt < 2; ++mt) {
            const bf16* vv = vt + (size_t)(32 * mt) * ldv + 16 * s2;
            const u32x2 a0 = *(const u32x2*)vv, a1 = *(const u32x2*)(vv + 8);
            v4u aw; aw.x = a0.x; aw.y = a0.y; aw.z = a1.x; aw.w = a1.y;
            o[mt] = __builtin_amdgcn_mfma_f32_32x32x16_bf16(__builtin_bit_cast(bf16x8, aw), __builtin_bit_cast(bf16x8, bw), o[mt], 0, 0, 0);
        }
    }
}

constexpr int NSA_IMP_OFF = 0;
constexpr int NSA_OACC_LD = 65;
constexpr int NSA_OACC_OFF = 0, NSA_LACC_OFF = 66560, NSA_MREF_OFF = 67584, NSA_MASK_OFF = 68608, NSA_CNT_OFF = 70656, NSA_SEL_OFF = 70912, NSA_QS_OFF = 75008;
constexpr int NSA_QS_LD = 72;
static_assert(NSA_QS_OFF + 256 * NSA_QS_LD * 2 <= RING_BYTES, "nsa lds");
constexpr int CW_KNORM = 49408;
typedef float f32x4_t __attribute__((ext_vector_type(4)));

__device__ __forceinline__ void p4_nsa_item(Frame& F, int T, int g) {
    const int tid = F.tid, lane = F.lane, w = F.wave, l31 = lane & 31, hi = lane >> 5, ql = l31 >> 2, hd = l31 & 3;
    const int t0 = 64 * T, t = t0 + 8 * w + ql, cur = T;
    LAS float* imp = (LAS float*)(F.lds + NSA_IMP_OFF) + (8 * w) * 256;
    LAS float* oacc = (LAS float*)(F.lds + NSA_OACC_OFF);
    LAS float* lacc = (LAS float*)(F.lds + NSA_LACC_OFF);
    LAS float* mref = (LAS float*)(F.lds + NSA_MREF_OFF);
    LAS unsigned* maskw = (LAS unsigned*)(F.lds + NSA_MASK_OFF);
    LAS int* cnt = (LAS int*)(F.lds + NSA_CNT_OFF);
    LAS int* selb = (LAS int*)(F.lds + NSA_SEL_OFF) + w * 128;
    LAS bf16* Qs = (LAS bf16*)(F.lds + NSA_QS_OFF);
#pragma unroll
    for (int i = 0; i < 32; ++i) imp[i * 64 + lane] = 0.f;
    maskw[tid] = 0u; if (tid < 256) lacc[tid] = 0.f; if (tid == 0) cnt[0] = 0;
    {
        const float bg = sqrtf(__uint_as_float(__hip_atomic_load((unsigned*)(F.ctl + CW_KNORM) + g, RLX_AGENT)));
#pragma unroll
        for (int i = 0; i < 4; ++i) {
            const int ch = tid + 512 * i, col = ch >> 3, c8 = ch & 7, qq = col >> 2, hh = col & 3;
            const v4u v = *(const v4u*)((const bf16*)(F.ws + WS_Q) + (size_t)(t0 + qq) * 512 + (g * 4 + hh) * 64 + c8 * 8);
            *(LAS v4u*)(Qs + col * NSA_QS_LD + c8 * 8) = v;
            float ss = 0.f;
#pragma unroll
            for (int k = 0; k < 4; ++k) { const unsigned u = k == 0 ? v.x : k == 1 ? v.y : k == 2 ? v.z : v.w; const float a = __uint_as_float(u << 16), b = __uint_as_float(u & 0xffff0000u); ss += a * a + b * b; }
            ss += __shfl_xor(ss, 1); ss += __shfl_xor(ss, 2); ss += __shfl_xor(ss, 4);
            if (c8 == 0) mref[col] = sqrtf(ss) * bg * 1.0001f + 1e-6f;
        }
    }
    __syncthreads();
    bf16x8 qf[4];
    { const bf16* qp = (const bf16*)(F.ws + WS_Q) + (size_t)t * 512 + (g * 4 + hd) * 64 + 8 * hi;
#pragma unroll
      for (int ks = 0; ks < 4; ++ks) qf[ks] = *(const bf16x8*)(qp + 16 * ks); }
    const float* gt = (const float*)(F.ws + WS_GATES) + (size_t)t * 32 + (g * 4 + hd) * 3;
    const float g_cmp = gt[0], g_sel = gt[1], g_win = gt[2];
    f32x16 o[2]; o[0] = (f32x16){}; o[1] = (f32x16){};
    {
        const bf16* kc = (const bf16*)(F.ws + WS_KCMP) + (size_t)l31 * 128 + g * 64 + 8 * hi;
        const bf16* vc = (const bf16*)(F.ws + WS_VCMPT) + (size_t)(g * 64 + l31) * 1024 + 4 * hi;
        const int ntile = (4 * T + 2) / 32 + 1;
        float m = NEGF, l = 0.f;
        for (int i = 0; i < ntile; ++i) { const f32x16 s = nsa_qk(kc + (size_t)(32 * i) * 128, qf); nsa_stats<0>(s, 32 * i, t, true, hi, m, l); }
        nsa_merge_halves(m, l);
        for (int i = 0; i < ntile; ++i) {
            const f32x16 s = nsa_qk(kc + (size_t)(32 * i) * 128, qf);
            float p[16]; nsa_probs<0>(s, 32 * i, t, true, hi, m, l, p);
#pragma unroll
            for (int q4 = 0; q4 < 4; ++q4) {
                float a = (p[4 * q4] + p[4 * q4 + 1]) + p[4 * q4 + 2], b = 0.5f * p[4 * q4 + 3];
                a += __shfl_xor(a, 1); a += __shfl_xor(a, 2); b += __shfl_xor(b, 1); b += __shfl_xor(b, 2);
                const int j = 8 * i + 2 * q4 + hi;
                if (hd == 0) { __hip_atomic_fetch_add(imp + ql * 256 + j, a + b, __ATOMIC_RELAXED, __HIP_MEMORY_SCOPE_WORKGROUP);
                               if (j + 1 < 256) __hip_atomic_fetch_add(imp + ql * 256 + j + 1, b, __ATOMIC_RELAXED, __HIP_MEMORY_SCOPE_WORKGROUP); }
            }
            nsa_pv(o, vc + 32 * i, 1024, p, g_cmp);
        }
    }
    const int nsel = cur + 1 < 16 ? cur + 1 : 16;
    LDS_WAIT();
    for (int qq = 0; qq < 8; ++qq) {
        float v[4];
#pragma unroll
        for (int i = 0; i < 4; ++i) { const int j = lane + 64 * i; float x = imp[qq * 256 + j];
            if (j == 0 || j == cur || j == cur - 1) x = BIGF; if (j > cur) x = NEGF; v[i] = x; }
        for (int k = 0; k < nsel; ++k) {
            float bv = v[0]; int bj = lane;
#pragma unroll
            for (int i = 1; i < 4; ++i) if (v[i] > bv) { bv = v[i]; bj = lane + 64 * i; }
#pragma unroll
            for (int off = 32; off >= 1; off >>= 1) { const float ov = __shfl_xor(bv, off); const int oj = __shfl_xor(bj, off); if (ov > bv || (ov == bv && oj < bj)) { bv = ov; bj = oj; } }
            if (lane == 0) { const int qi = 8 * w + qq; __hip_atomic_fetch_or(maskw + 2 * bj + (qi >> 5), 1u << (qi & 31), __ATOMIC_RELAXED, __HIP_MEMORY_SCOPE_WORKGROUP); }
#pragma unroll
            for (int i = 0; i < 4; ++i) if (lane + 64 * i == bj) v[i] = -3e38f;
        }
    }
    {
        const bf16* kwb = (const bf16*)(F.ws + WS_KW) + (size_t)l31 * 128 + g * 64 + 8 * hi;
        const bf16* vwb = (const bf16*)(F.ws + WS_VWT) + (size_t)(g * 64 + l31) * S + 4 * hi;
        const int kb0 = t0 - 512 < 0 ? 0 : t0 - 512, kb1 = t0 + 64;
        float m = NEGF, l = 0.f;
        for (int kb = kb0; kb < kb1; kb += 32) { const f32x16 s = nsa_qk(kwb + (size_t)kb * 128, qf); nsa_stats<1>(s, kb, t, true, hi, m, l); }
        nsa_merge_halves(m, l);
        for (int kb = kb0; kb < kb1; kb += 32) { const f32x16 s = nsa_qk(kwb + (size_t)kb * 128, qf);
            float p[16]; nsa_probs<1>(s, kb, t, true, hi, m, l, p); nsa_pv(o, vwb + kb, S, p, g_win); }
    }
    __syncthreads();
    for (int i = tid; i < 256 * NSA_OACC_LD; i += 512) oacc[i] = 0.f;
    __syncthreads();
    {
        const int c15 = lane & 15, q4 = lane >> 4, slot = (lane >> 2) & 3, hd4 = lane & 3;
        const bf16* ksb = (const bf16*)(F.ws + WS_KS) + (size_t)c15 * 128 + g * 64 + 8 * q4;
        const bf16* vsb = (const bf16*)(F.ws + WS_VST) + (size_t)(g * 64 + c15) * S + 4 * q4;
        for (;;) {
            int idx = 0; if (lane == 0) idx = __hip_atomic_fetch_add(cnt, 1, __ATOMIC_RELAXED, __HIP_MEMORY_SCOPE_WORKGROUP);
            idx = __builtin_amdgcn_readfirstlane(idx);
            if (idx > cur) break;
            const int j = idx == 0 ? 0 : cur - (idx - 1);
            unsigned mlo = __builtin_amdgcn_readfirstlane(maskw[2 * j]), mhi = __builtin_amdgcn_readfirstlane(maskw[2 * j + 1]);
            unsigned long long mm = ((unsigned long long)mhi << 32) | mlo;
            if (mm == 0ull) continue;
            bf16x8 Kf[4][2]; bf16x8 Vf[4][2];
#pragma unroll
            for (int mt = 0; mt < 4; ++mt)
#pragma unroll
                for (int k2 = 0; k2 < 2; ++k2) Kf[mt][k2] = *(const bf16x8*)(ksb + (size_t)(64 * j + 16 * mt) * 128 + 32 * k2);
#pragma unroll
            for (int dt = 0; dt < 4; ++dt)
#pragma unroll
                for (int kh = 0; kh < 2; ++kh) { const bf16* vv = vsb + (size_t)(16 * dt) * S + 64 * j + 32 * kh;
                    const u32x2 a0 = *(const u32x2*)vv, a1 = *(const u32x2*)(vv + 16); v4u aw; aw.x = a0.x; aw.y = a0.y; aw.z = a1.x; aw.w = a1.y; Vf[dt][kh] = __builtin_bit_cast(bf16x8, aw); }
            while (mm != 0ull) {
                int qs0, qs1, qs2, qs3, n = 1;
                qs0 = __builtin_ctzll(mm); mm &= mm - 1; qs1 = qs0; qs2 = qs0; qs3 = qs0;
                if (mm) { qs1 = __builtin_ctzll(mm); mm &= mm - 1; n = 2; if (mm) { qs2 = __builtin_ctzll(mm); mm &= mm - 1; n = 3; if (mm) { qs3 = __builtin_ctzll(mm); mm &= mm - 1; n = 4; } } }
                const int qi = slot == 0 ? qs0 : slot == 1 ? qs1 : slot == 2 ? qs2 : qs3; const bool active = slot < n;
                const int col = qi * 4 + hd4, tq = t0 + qi;
                const bf16x8 qb0 = *(const LAS bf16x8*)(Qs + col * NSA_QS_LD + 8 * q4), qb1 = *(const LAS bf16x8*)(Qs + col * NSA_QS_LD + 32 + 8 * q4);
                const float mr = mref[col];
                f32x4_t sacc[4];
#pragma unroll
                for (int mt = 0; mt < 4; ++mt) { f32x4_t z = {0.f, 0.f, 0.f, 0.f};
                    z = __builtin_amdgcn_mfma_f32_16x16x32_bf16(Kf[mt][0], qb0, z, 0, 0, 0); z = __builtin_amdgcn_mfma_f32_16x16x32_bf16(Kf[mt][1], qb1, z, 0, 0, 0); sacc[mt] = z; }
                float ls = 0.f; unsigned pk[4][2];
#pragma unroll
                for (int mt = 0; mt < 4; ++mt) { float p[4];
#pragma unroll
                    for (int r = 0; r < 4; ++r) { const bool v = active && (64 * j + 16 * mt + 4 * q4 + r <= tq); p[r] = v ? exp2f(sacc[mt][r] - mr) : 0.f; ls += p[r]; }
                    pk[mt][0] = cvtpk(p[0], p[1]); pk[mt][1] = cvtpk(p[2], p[3]); }
                ls += __shfl_xor(ls, 16); ls += __shfl_xor(ls, 32);
                if (q4 == 0 && active) __hip_atomic_fetch_add(lacc + col, ls, __ATOMIC_RELAXED, __HIP_MEMORY_SCOPE_WORKGROUP);
                v4u pb0, pb1; pb0.x = pk[0][0]; pb0.y = pk[0][1]; pb0.z = pk[1][0]; pb0.w = pk[1][1]; pb1.x = pk[2][0]; pb1.y = pk[2][1]; pb1.z = pk[3][0]; pb1.w = pk[3][1];
#pragma unroll
                for (int dt = 0; dt < 4; ++dt) { f32x4_t z = {0.f, 0.f, 0.f, 0.f};
                    z = __builtin_amdgcn_mfma_f32_16x16x32_bf16(Vf[dt][0], __builtin_bit_cast(bf16x8, pb0), z, 0, 0, 0); z = __builtin_amdgcn_mfma_f32_16x16x32_bf16(Vf[dt][1], __builtin_bit_cast(bf16x8, pb1), z, 0, 0, 0);
                    if (active) {
#pragma unroll
                        for (int r = 0; r < 4; ++r) __hip_atomic_fetch_add(oacc + col * NSA_OACC_LD + 16 * dt + 4 * q4 + r, z[r], __ATOMIC_RELAXED, __HIP_MEMORY_SCOPE_WORKGROUP); }
                }
            }
        }
    }
    __syncthreads();
    {
        const int col = (8 * w + ql) * 4 + hd; const float sc = g_sel / lacc[col];
        bf16* op = (bf16*)(F.dout + DO_NSA) + (size_t)t * 512 + (g * 4 + hd) * 64 + 4 * hi;
#pragma unroll
        for (int mt = 0; mt < 2; ++mt)
#pragma unroll
            for (int q4 = 0; q4 < 4; ++q4) { float r4[4];
#pragma unroll
                for (int r = 0; r < 4; ++r) r4[r] = o[mt][4 * q4 + r] + sc * oacc[col * NSA_OACC_LD + 32 * mt + 8 * q4 + 4 * hi + r];
                u32x2 v; v.x = cvtpk(r4[0], r4[1]); v.y = cvtpk(r4[2], r4[3]); *(u32x2*)(op + 32 * mt + 8 * q4) = v; }
    }
    __syncthreads();
}
#if DBG_MODE == 3
constexpr int NSA0_SEL_OFF = 65536;
__device__ __forceinline__ void p4_nsa_item_v0(Frame& F, int T, int g, bf16* outbuf) {
    const int lane = F.lane, w = F.wave, l31 = lane & 31, hi = lane >> 5, ql = l31 >> 2, hd = l31 & 3;
    const int t0 = 64 * T, t = t0 + 8 * w + ql, cur = T;
    LAS float* imp = (LAS float*)(F.lds + 0) + (8 * w) * 256;
    LAS int* selb = (LAS int*)(F.lds + NSA0_SEL_OFF) + w * 128;
#pragma unroll
    for (int i = 0; i < 32; ++i) imp[i * 64 + lane] = 0.f;
    bf16x8 qf[4];
    { const bf16* qp = (const bf16*)(F.ws + WS_Q) + (size_t)t * 512 + (g * 4 + hd) * 64 + 8 * hi;
#pragma unroll
      for (int ks = 0; ks < 4; ++ks) qf[ks] = *(const bf16x8*)(qp + 16 * ks); }
    const float* gt = (const float*)(F.ws + WS_GATES) + (size_t)t * 32 + (g * 4 + hd) * 3;
    const float g_cmp = gt[0], g_sel = gt[1], g_win = gt[2];
    f32x16 o[2]; o[0] = (f32x16){}; o[1] = (f32x16){};
    {
        const bf16* kc = (const bf16*)(F.ws + WS_KCMP) + (size_t)l31 * 128 + g * 64 + 8 * hi;
        const bf16* vc = (const bf16*)(F.ws + WS_VCMPT) + (size_t)(g * 64 + l31) * 1024 + 4 * hi;
        const int ntile = (4 * T + 2) / 32 + 1;
        float m = NEGF, l = 0.f;
        for (int i = 0; i < ntile; ++i) { const f32x16 s = nsa_qk(kc + (size_t)(32 * i) * 128, qf); nsa_stats<0>(s, 32 * i, t, true, hi, m, l); }
        nsa_merge_halves(m, l);
        for (int i = 0; i < ntile; ++i) {
            const f32x16 s = nsa_qk(kc + (size_t)(32 * i) * 128, qf);
            float p[16]; nsa_probs<0>(s, 32 * i, t, true, hi, m, l, p);
#pragma unroll
            for (int q4 = 0; q4 < 4; ++q4) {
                float a = (p[4 * q4] + p[4 * q4 + 1]) + p[4 * q4 + 2], b = 0.5f * p[4 * q4 + 3];
                a += __shfl_xor(a, 1); a += __shfl_xor(a, 2); b += __shfl_xor(b, 1); b += __shfl_xor(b, 2);
                const int j = 8 * i + 2 * q4 + hi;
                if (hd == 0) { __hip_atomic_fetch_add(imp + ql * 256 + j, a + b, __ATOMIC_RELAXED, __HIP_MEMORY_SCOPE_WORKGROUP);
                               if (j + 1 < 256) __hip_atomic_fetch_add(imp + ql * 256 + j + 1, b, __ATOMIC_RELAXED, __HIP_MEMORY_SCOPE_WORKGROUP); }
            }
            nsa_pv(o, vc + 32 * i, 1024, p, g_cmp);
        }
    }
    const int nsel = cur + 1 < 16 ? cur + 1 : 16;
    LDS_WAIT();
    for (int qq = 0; qq < 8; ++qq) {
        float v[4];
#pragma unroll
        for (int i = 0; i < 4; ++i) { const int j = lane + 64 * i; float x = imp[qq * 256 + j];
            if (j == 0 || j == cur || j == cur - 1) x = BIGF; if (j > cur) x = NEGF; v[i] = x; }
        for (int k = 0; k < nsel; ++k) {
            float bv = v[0]; int bj = lane;
#pragma unroll
            for (int i = 1; i < 4; ++i) if (v[i] > bv) { bv = v[i]; bj = lane + 64 * i; }
#pragma unroll
            for (int off = 32; off >= 1; off >>= 1) { const float ov = __shfl_xor(bv, off); const int oj = __shfl_xor(bj, off); if (ov > bv || (ov == bv && oj < bj)) { bv = ov; bj = oj; } }
            if (lane == 0) selb[qq * 16 + k] = bj;
#pragma unroll
            for (int i = 0; i < 4; ++i) if (lane + 64 * i == bj) v[i] = -3e38f;
        }
    }
    LDS_WAIT();
    {
        const bf16* ksb = (const bf16*)(F.ws + WS_KS) + (size_t)l31 * 128 + g * 64 + 8 * hi;
        const bf16* vsb = (const bf16*)(F.ws + WS_VST) + (size_t)(g * 64 + l31) * S + 4 * hi;
        float m = NEGF, l = 0.f;
        for (int qq = 0; qq < 8; ++qq) { const bool colsel = ql == qq;
            for (int k = 0; k < nsel; ++k) { const int j = __builtin_amdgcn_readfirstlane(selb[qq * 16 + k]);
#pragma unroll
                for (int u = 0; u < 2; ++u) { const int kb = 64 * j + 32 * u; const f32x16 s = nsa_qk(ksb + (size_t)kb * 128, qf); nsa_stats<2>(s, kb, t, colsel, hi, m, l); } } }
        nsa_merge_halves(m, l);
        for (int qq = 0; qq < 8; ++qq) { const bool colsel = ql == qq;
            for (int k = 0; k < nsel; ++k) { const int j = __builtin_amdgcn_readfirstlane(selb[qq * 16 + k]);
#pragma unroll
                for (int u = 0; u < 2; ++u) { const int kb = 64 * j + 32 * u; const f32x16 s = nsa_qk(ksb + (size_t)kb * 128, qf);
                    float p[16]; nsa_probs<2>(s, kb, t, colsel, hi, m, l, p); nsa_pv(o, vsb + kb, S, p, g_sel); } } }
    }
    {
        const bf16* kwb = (const bf16*)(F.ws + WS_KW) + (size_t)l31 * 128 + g * 64 + 8 * hi;
        const bf16* vwb = (const bf16*)(F.ws + WS_VWT) + (size_t)(g * 64 + l31) * S + 4 * hi;
        const int kb0 = t0 - 512 < 0 ? 0 : t0 - 512, kb1 = t0 + 64;
        float m = NEGF, l = 0.f;
        for (int kb = kb0; kb < kb1; kb += 32) { const f32x16 s = nsa_qk(kwb + (size_t)kb * 128, qf); nsa_stats<1>(s, kb, t, true, hi, m, l); }
        nsa_merge_halves(m, l);
        for (int kb = kb0; kb < kb1; kb += 32) { const f32x16 s = nsa_qk(kwb + (size_t)kb * 128, qf);
            float p[16]; nsa_probs<1>(s, kb, t, true, hi, m, l, p); nsa_pv(o, vwb + kb, S, p, g_win); }
    }
    bf16* op = outbuf + (size_t)t * 512 + (g * 4 + hd) * 64 + 4 * hi;
#pragma unroll
    for (int mt = 0; mt < 2; ++mt)
#pragma unroll
        for (int q4 = 0; q4 < 4; ++q4) { u32x2 v; v.x = cvtpk(o[mt][4 * q4], o[mt][4 * q4 + 1]); v.y = cvtpk(o[mt][4 * q4 + 2], o[mt][4 * q4 + 3]); *(u32x2*)(op + 32 * mt + 8 * q4) = v; }
}


#endif
#ifndef DBG_MODE
#define DBG_MODE 0
#endif
#if DBG_MODE
constexpr int CW_DBG = 49152;
__device__ __forceinline__ void dbg_amax(unsigned* p, float v) { atomicMax(p, __float_as_uint(fabsf(v))); }
__device__ __forceinline__ float blk_reduce(LAS float* red, float v, bool ismax, int tid) {
    red[tid] = v; __syncthreads();
    for (int s = 256; s >= 1; s >>= 1) { if (tid < s) red[tid] = ismax ? fmaxf(red[tid], red[tid + s]) : red[tid] + red[tid + s]; __syncthreads(); }
    const float r = red[0]; __syncthreads(); return r;
}
__device__ __forceinline__ void dbg_softmax(LAS float* sc, LAS float* vl, int n, LAS float* red, int tid) {
    for (int h = 0; h < 4; ++h) {
        float m = NEGF; for (int i = tid; i < n; i += 512) if (vl[i] != 0.f) m = fmaxf(m, sc[h * 1024 + i]);
        m = blk_reduce(red, m, true, tid);
        float l = 0.f; for (int i = tid; i < n; i += 512) if (vl[i] != 0.f) l += exp2f(sc[h * 1024 + i] - m);
        l = blk_reduce(red, l, false, tid);
        for (int i = tid; i < n; i += 512) sc[h * 1024 + i] = (vl[i] != 0.f && l > 0.f) ? exp2f(sc[h * 1024 + i] - m) / l : 0.f;
        __syncthreads();
    }
}
__device__ __forceinline__ void dbg_nsa_check(Frame& F, int t, int g) {
    const int tid = F.tid;
    LAS float* sc = (LAS float*)F.lds;
    LAS float* vl = sc + 4096;
    LAS float* red = vl + 1024;
    LAS float* qv = red + 512;
    LAS float* impv = qv + 256;
    LAS float* ob = impv + 256;
    LAS int* sel = (LAS int*)(ob + 768);
    const bf16* Q = (const bf16*)(F.ws + WS_Q); const bf16* KC = (const bf16*)(F.ws + WS_KCMP); const bf16* VCT = (const bf16*)(F.ws + WS_VCMPT);
    const bf16* KS = (const bf16*)(F.ws + WS_KS); const bf16* VST = (const bf16*)(F.ws + WS_VST); const bf16* KW = (const bf16*)(F.ws + WS_KW); const bf16* VWT = (const bf16*)(F.ws + WS_VWT);
    __syncthreads();
    if (tid < 256) qv[tid] = bf2f(Q[(size_t)t * 512 + g * 256 + tid]);
    __syncthreads();
    for (int i = tid; i < 1024; i += 512) vl[i] = (i < 1023 && 16 * i + 31 <= t) ? 1.f : 0.f;
    for (int i = tid; i < 4096; i += 512) { const int h = i >> 10, c = i & 1023; float a = 0.f;
        if (c < 1023) for (int d = 0; d < 64; ++d) a += qv[h * 64 + d] * bf2f(KC[(size_t)c * 128 + g * 64 + d]);
        sc[i] = a; }
    __syncthreads();
    dbg_softmax(sc, vl, 1023, red, tid);
    if (tid < 256) { const int h = tid >> 6, d = tid & 63; float a = 0.f; for (int c = 0; c < 1023; ++c) a += sc[h * 1024 + c] * bf2f(VCT[(size_t)(g * 64 + d) * 1024 + c]); ob[tid] = a; }
    if (tid < 256) { const int j = tid; float a = 0.f;
        for (int c = 0; c < 1023; ++c) { int lo = 16 * c > 64 * j ? 16 * c : 64 * j, hi2 = (16 * c + 32 < 64 * j + 64) ? 16 * c + 32 : 64 * j + 64; int ov = hi2 - lo; if (ov < 0) ov = 0;
            if (ov > 0) a += (sc[c] + sc[1024 + c] + sc[2048 + c] + sc[3072 + c]) * ((float)ov / 32.0f); }
        const int cur = t / 64;
        if (j == 0 || j == cur || j == cur - 1) a = BIGF; else if (j > cur) a = NEGF;
        impv[j] = a; }
    __syncthreads();
    if (tid == 0) { for (int k = 0; k < 16; ++k) { float bv = -3e38f; int bj = 0; for (int j = 0; j < 256; ++j) if (impv[j] > bv) { bv = impv[j]; bj = j; } sel[k] = bj; impv[bj] = -3.2e38f; } }
    __syncthreads();
    for (int i = tid; i < 1024; i += 512) { const int pos = sel[i >> 6] * 64 + (i & 63); vl[i] = pos <= t ? 1.f : 0.f; }
    for (int i = tid; i < 4096; i += 512) { const int h = i >> 10, sI = i & 1023, pos = sel[sI >> 6] * 64 + (sI & 63); float a = 0.f;
        for (int d = 0; d < 64; ++d) a += qv[h * 64 + d] * bf2f(KS[(size_t)pos * 128 + g * 64 + d]);
        sc[i] = a; }
    __syncthreads();
    dbg_softmax(sc, vl, 1024, red, tid);
    if (tid < 256) { const int h = tid >> 6, d = tid & 63; float a = 0.f; for (int i = 0; i < 1024; ++i) { const int pos = sel[i >> 6] * 64 + (i & 63); a += sc[h * 1024 + i] * bf2f(VST[(size_t)(g * 64 + d) * S + pos]); } ob[256 + tid] = a; }
    __syncthreads();
    for (int i = tid; i < 1024; i += 512) { const int pos = t - 511 + i; vl[i] = (i < 512 && pos >= 0) ? 1.f : 0.f; }
    for (int i = tid; i < 4096; i += 512) { const int h = i >> 10, sI = i & 1023, pos = t - 511 + sI; float a = 0.f;
        if (sI < 512 && pos >= 0) for (int d = 0; d < 64; ++d) a += qv[h * 64 + d] * bf2f(KW[(size_t)pos * 128 + g * 64 + d]);
        sc[i] = a; }
    __syncthreads();
    dbg_softmax(sc, vl, 512, red, tid);
    if (tid < 256) { const int h = tid >> 6, d = tid & 63; float a = 0.f; for (int i = 0; i < 512; ++i) { const int pos = t - 511 + i; if (pos >= 0) a += sc[h * 1024 + i] * bf2f(VWT[(size_t)(g * 64 + d) * S + pos]); } ob[512 + tid] = a; }
    __syncthreads();
    if (tid < 256) { const int h = tid >> 6; const float* gt = (const float*)(F.ws + WS_GATES) + (size_t)t * 32 + (g * 4 + h) * 3;
        const float ref = gt[0] * ob[tid] + gt[1] * ob[256 + tid] + gt[2] * ob[512 + tid];
        const float got = bf2f(((const bf16*)(F.dout + DBG_NSA_SRC))[(size_t)t * 512 + g * 256 + tid]);
        dbg_amax((unsigned*)(F.ctl + CW_DBG), (ref - got) / (fabsf(ref) + 0.05f)); dbg_amax((unsigned*)(F.ctl + CW_DBG) + 1, ref - got); }
    __syncthreads();
}
#endif

#if DBG_MODE == 2
__device__ __forceinline__ void dbg_proj_check(Frame& F, const Args& a, int t) {
    const int tid = F.tid;
    LAS float* hrow = (LAS float*)F.lds;
    LAS float* outv = hrow + 1024;
    LAS float* red = outv + 1408;
    const float* x = (const float*)a.in[0] + (size_t)t * D; const float* gm = (const float*)a.in[2]; const float* W = (const float*)a.in[3];
    __syncthreads();
    float ss = 0.f; for (int k = tid; k < D; k += 512) ss += x[k] * x[k];
    ss = blk_reduce(red, ss, false, tid);
    const float rstd = 1.0f / sqrtf(ss / (float)D + NORM_EPS);
    for (int k = tid; k < D; k += 512) hrow[k] = x[k] * rstd * gm[k];
    __syncthreads();
    for (int c = tid; c < 1304; c += 512) { float acc = 0.f; for (int k = 0; k < D; ++k) acc += hrow[k] * W[(size_t)k * INW + c]; outv[c] = acc; }
    __syncthreads();
    const float p = (float)((const int*)a.in[1])[t];
    if (tid < 14 * 8) { const int hd = tid >> 3, i = tid & 7;
        int base; if (hd < 8) base = hd * 64; else { const int b = (hd - 8) >> 1, g = (hd - 8) & 1; base = 512 + b * 256 + g * 64; }
        float tt = -13.122363377404328f * (float)i; tt = tt * 2.0f; tt = tt / 16.0f; const float ang = p * expf(tt);
        const float cs = cosf(ang), sn = sinf(ang); const float x1 = outv[base + i], x2 = outv[base + 8 + i];
        outv[base + i] = x1 * cs - x2 * sn; outv[base + 8 + i] = x1 * sn + x2 * cs; }
    __syncthreads();
    unsigned* dE = (unsigned*)(F.ctl + CW_DBG);
    for (int c = tid; c < 1304; c += 512) {
        float ref = outv[c], got;
        if (c < 512) { ref *= QSCALE; got = bf2f(((const bf16*)(F.ws + WS_Q))[(size_t)t * 512 + c]); }
        else if (c < 1280) { const int b = (c - 512) >> 7, cc = (c - 512) & 127;
            if (b == 0) got = bf2f(((const bf16*)(F.ws + WS_KC))[(size_t)t * 128 + cc]);
            else if (b == 1) got = bf2f(((const bf16*)(F.ws + WS_VC))[(size_t)t * 128 + cc]);
            else if (b == 2) got = bf2f(((const bf16*)(F.ws + WS_KS))[(size_t)t * 128 + cc]);
            else if (b == 3) got = bf2f(((const bf16*)(F.ws + WS_VST))[(size_t)cc * S + t]);
            else if (b == 4) got = bf2f(((const bf16*)(F.ws + WS_KW))[(size_t)t * 128 + cc]);
            else got = bf2f(((const bf16*)(F.ws + WS_VWT))[(size_t)cc * S + t]); }
        else { ref = 1.0f / (1.0f + expf(-ref)); got = ((const float*)(F.ws + WS_GATES))[(size_t)t * 32 + (c - 1280)]; }
        dbg_amax(dE, (ref - got) / (fabsf(ref) + 0.25f));
    }
    __syncthreads();
}
__device__ __forceinline__ void dbg_cmp_check(Frame& F, const Args& a, int c, int g, int kind) {
    const int tid = F.tid;
    LAS float* blk = (LAS float*)F.lds;
    LAS float* hid = blk + 2048;
    const bf16* src = (const bf16*)(F.ws + (kind ? WS_VC : WS_KC)); const float* pe = (const float*)a.in[kind ? 5 : 4];
    const float* w1 = (const float*)a.in[kind ? 8 : 6]; const float* w2 = (const float*)a.in[kind ? 9 : 7];
    __syncthreads();
    for (int k = tid; k < 2048; k += 512) { const int l = k >> 6, d = k & 63; blk[k] = bf2f(src[(size_t)(16 * c + l) * 128 + g * 64 + d]) + pe[l * 64 + d]; }
    __syncthreads();
    if (tid < 256) { float acc = 0.f; for (int k = 0; k < 2048; ++k) acc += blk[k] * w1[(size_t)k * 256 + tid]; hid[tid] = acc / (1.0f + expf(-acc)); }
    __syncthreads();
    if (tid < 64) { float acc = 0.f; for (int j = 0; j < 256; ++j) acc += hid[j] * w2[j * 64 + tid];
        const float got = kind ? bf2f(((const bf16*)(F.ws + WS_VCMPT))[(size_t)(g * 64 + tid) * 1024 + c]) : bf2f(((const bf16*)(F.ws + WS_KCMP))[(size_t)c * 128 + g * 64 + tid]);
        dbg_amax((unsigned*)(F.ctl + CW_DBG) + 1, (acc - got) / (fabsf(acc) + 0.1f)); }
    __syncthreads();
}
#endif

__global__ void __launch_bounds__(512, 2) fwd_megakernel(Args args) {
    extern __shared__ __attribute__((aligned(16))) unsigned char lds[];
    Frame F;
    F.lds = (LAS unsigned char*)lds;
    F.MISC = (volatile LAS unsigned*)(F.lds + MISC_OFF);
    F.tid = threadIdx.x; F.lane = F.tid & 63; F.wave = __builtin_amdgcn_readfirstlane(F.tid >> 6);
    F.G = gridDim.x; { const int bx = blockIdx.x; F.vcu = (F.G % 8 == 0) ? (bx % 8) * (F.G / 8) + bx / 8 : bx; }
    F.ws = args.ws; F.dout = (unsigned char*)args.out;
    F.ctl = (gu32*)(args.ws + WS_CTL);
    for (int u = F.tid; u < (LDS_BYTES - LDSCTL_OFF) / 4; u += 512) ((LAS unsigned*)(F.lds + LDSCTL_OFF))[u] = 0u;
    __syncthreads();
    XcdBarrier bar = xcd_barrier_post((unsigned*)(F.ctl + CW_BAR), F.MISC + 8);
    unsigned char* ws = args.ws;
    const int G = F.G, bid = blockIdx.x;

    if (PHASE_MASK & 1) p0_prologue(F, args);
    xcd_barrier(bar);
    if (PHASE_MASK & 2) {
        pg8::Gemm g{(const bf16_t*)(ws + WS_XB), (const bf16_t*)(ws + WS_XB), (const bf16_t*)(ws + WS_WIN), (const bf16_t*)(ws + WS_WIN), D};
        pg8::StaticOrder So; So.init(S, NVIRT, G, bid);
        Epi1 E{ws, (const int*)args.in[1]};
        pg8::gemm_phase<Epi1, pg8::StaticOrder, true, true>(F.lds, g, So, E);
    }
    xcd_barrier(bar);
    if (PHASE_MASK & 4) {
        {
            const int gth = (F.vcu * 8 + F.wave) * 64 + F.lane; float mx = 0.f;
            for (int i = gth; i < 2 * S; i += G * 512) { const bf16* kp = (const bf16*)(ws + WS_KS) + (size_t)(i >> 1) * 128 + (i & 1) * 64; float ss = 0.f;
#pragma unroll
                for (int c = 0; c < 8; ++c) { const v4u v = *(const v4u*)(kp + 8 * c);
#pragma unroll
                    for (int k = 0; k < 4; ++k) { const unsigned u = k == 0 ? v.x : k == 1 ? v.y : k == 2 ? v.z : v.w; const float a = __uint_as_float(u << 16), b = __uint_as_float(u & 0xffff0000u); ss += a * a + b * b; } }
                const float o1 = __shfl_xor(ss, 1);
                (void)o1; mx = fmaxf(mx, ss); }
#pragma unroll
            for (int off = 2; off < 64; off <<= 1) mx = fmaxf(mx, __shfl_xor(mx, off));
            if (F.lane < 2) atomicMax((unsigned*)(F.ctl + CW_KNORM) + F.lane, __float_as_uint(mx));
        }
        for (int it = bid; it < 128; it += G) p2_compress_item(F, args, it);
    for (int it = bid; it < 512; it += G) p2_kv_item(F, it); }
    xcd_barrier(bar);
    if (PHASE_MASK & 8) p3_scan(F);
    xcd_barrier(bar);
    if (PHASE_MASK & 16) { for (int it = bid; it < 512; it += G) { const int T = it < 256 ? it : 511 - it, g = it >> 8; p4_nsa_item(F, T, g); } }
    if (PHASE_MASK & 1024) { for (int pi = bid; pi < 256; pi += G) p4_ret_item(F, 2 * pi + (F.wave >> 2), F.wave & 3); }
    xcd_barrier(bar);
#if DBG_MODE == 3
    {
        for (int it = bid; it < 512; it += G) { const int T = it < 256 ? it : 511 - it, g = it >> 8; p4_nsa_item_v0(F, T, g, (bf16*)(ws + WS_XB)); }
        xcd_barrier(bar);
        const bf16* a0 = (const bf16*)(ws + WS_XB); const bf16* a1 = (const bf16*)(F.dout + DO_NSA); float e = 0.f, e2 = 0.f;
        for (size_t i = (size_t)bid * 512 + F.tid; i < (size_t)S * 512; i += (size_t)G * 512) { const float r = bf2f(a0[i]), v = bf2f(a1[i]); e = fmaxf(e, fabsf(r - v) / (fabsf(r) + 0.05f)); e2 = fmaxf(e2, fabsf(r - v)); }
        dbg_amax((unsigned*)(F.ctl + CW_DBG), e); dbg_amax((unsigned*)(F.ctl + CW_DBG) + 1, e2);
        xcd_barrier(bar);
    }
#endif
#if DBG_MODE == 2
    {
        for (int si = bid; si < 512; si += G) {
            int t = (int)(((unsigned)si * 2654435761u) >> 18); if (si < 4) t = si == 0 ? 0 : si == 1 ? 16383 : si == 2 ? 255 : 256;
            dbg_proj_check(F, args, t);
            int c = (int)(((unsigned)(si + 7) * 2246822519u) >> 22); if (c > 1022) c = 1022; if (si < 2) c = si == 0 ? 0 : 1022;
            dbg_cmp_check(F, args, c, si & 1, (si >> 1) & 1);
        }
        xcd_barrier(bar);
    }
#endif
#if DBG_MODE == 1
    {
        for (int si = bid; si < 512; si += G) {
            const int edge[32] = {0, 1, 15, 30, 31, 32, 46, 47, 48, 63, 64, 65, 127, 128, 129, 191, 192, 511, 512, 513, 575, 576, 959, 960, 1023, 1024, 1087, 8191, 8192, 16320, 16382, 16383};
            int t = 0;
#pragma unroll
            for (int e = 0; e < 32; ++e) if ((si >> 1) == e) t = edge[e];
            if ((si >> 1) >= 32) t = (int)(((unsigned)(si >> 1) * 2654435761u) >> 18);
            dbg_nsa_check(F, t, si & 1);
        }
        xcd_barrier(bar);
    }
#endif
    if (PHASE_MASK & 32) {
        pg8::Gemm g{(const bf16_t*)(F.dout + DO_NSA), (const bf16_t*)(F.dout + DO_RET), (const bf16_t*)(ws + WS_WPA), (const bf16_t*)(ws + WS_WPB), 512};
        pg8::PairOrder Po; Po.so.init(S, D, G, bid);
        EpiMix E{ws};
        pg8::gemm_phase<EpiMix, pg8::PairOrder, false, true>(F.lds, g, Po, E);
    }
    xcd_barrier(bar);
    if (PHASE_MASK & 64) {
        pg8::Gemm g{(const bf16_t*)(ws + WS_MIX), (const bf16_t*)(ws + WS_MIX), (const bf16_t*)(ws + WS_WOUT), (const bf16_t*)(ws + WS_WOUT), D};
        pg8::StaticOrder So; So.init(S, D, G, bid);
        EpiRes<true> E{(const float*)args.in[0], args.out, (bf16_t*)(ws + WS_XB), (float*)(F.ctl + CW_SSQ2)};
        pg8::gemm_phase<EpiRes<true>, pg8::StaticOrder, false, true>(F.lds, g, So, E);
    }
    xcd_barrier(bar);
    if (PHASE_MASK & 128) {
        pg8::Gemm g{(const bf16_t*)(ws + WS_XB), (const bf16_t*)(ws + WS_XB), (const bf16_t*)(ws + WS_WUP), (const bf16_t*)(ws + WS_WUP), D};
        pg8::StaticOrder So; So.init(S, FF, G, bid);
        EpiUp E{(const float*)(F.ctl + CW_SSQ2), (bf16_t*)(ws + WS_HMID)};
        pg8::gemm_phase<EpiUp, pg8::StaticOrder, true, true>(F.lds, g, So, E);
    }
    xcd_barrier(bar);
    if (PHASE_MASK & 256) {
        pg8::Gemm g{(const bf16_t*)(ws + WS_HMID), (const bf16_t*)(ws + WS_HMID), (const bf16_t*)(ws + WS_WDN), (const bf16_t*)(ws + WS_WDN), FF};
        pg8::StaticOrder So; So.init(S, D, G, bid);
        EpiRes<false> E{args.out, args.out, nullptr, (float*)(F.ctl + CW_SSQ3)};
        pg8::gemm_phase<EpiRes<false>, pg8::StaticOrder, false, true>(F.lds, g, So, E);
    }
    xcd_barrier(bar);
    if (PHASE_MASK & 512) {
        const float* gf = (const float*)args.in[16]; const float* ssq = (const float*)(F.ctl + CW_SSQ3);
        const unsigned tmo = __hip_atomic_load((unsigned*)(F.ctl + CW_BAR) + XB_TMO, RLX_AGENT);
        const int gw = F.vcu * 8 + F.wave, NGW = G * 8;
        for (int m = gw; m < S; m += NGW) {
            GAS f32x4* xr = (GAS f32x4*)(args.out + (size_t)m * D) + F.lane;
            float rs = 1.0f / sqrtf(ssq[m] * (1.0f / D) + NORM_EPS);
            if (tmo) rs = __builtin_nanf("");
#pragma unroll
            for (int j = 0; j < 4; ++j) { const f32x4 gv = *((const f32x4*)gf + F.lane + 64 * j); f32x4 y = xr[64 * j] * rs * gv;
#if DBG_MODE
                {
                    const float E = __uint_as_float(__hip_atomic_load((unsigned*)(F.ctl + CW_DBG), RLX_AGENT)), X = __uint_as_float(__hip_atomic_load((unsigned*)(F.ctl + CW_DBG) + 1, RLX_AGENT));
                    if (m < 1024) y = y + 4.0f * sqrtf(E * DBG_ESCALE);
                    if (m == 0 && j == 0 && F.lane == 0) y.x += X * DBG_XSCALE;
                }
#endif
                xr[64 * j] = y; }
        }
    }
}

extern "C" void kernel_launch(void* const* d_in, const int* in_sizes, int n_in, void* d_out, int out_size, void* d_ws, size_t ws_size, hipStream_t stream) {
    static int grid = 0;
    if (grid == 0) {
        if (n_in != 17 || in_sizes[0] != S * D || out_size != S * D || ws_size < WS_END) { fprintf(stderr, "kernel_launch: unexpected shapes (n_in %d, in0 %d, out %d, ws %zu)\n", n_in, n_in > 0 ? in_sizes[0] : -1, out_size, ws_size); grid = -1; return; }
        int dev = 0, cus = 0, per_cu = 0;
        if (hipGetDevice(&dev) != hipSuccess || hipDeviceGetAttribute(&cus, hipDeviceAttributeMultiprocessorCount, dev) != hipSuccess) { grid = -1; return; }
        if (hipFuncSetAttribute((const void*)fwd_megakernel, hipFuncAttributeMaxDynamicSharedMemorySize, LDS_BYTES) != hipSuccess) { fprintf(stderr, "kernel_launch: hipFuncSetAttribute failed\n"); grid = -1; return; }
        if (hipOccupancyMaxActiveBlocksPerMultiprocessor(&per_cu, (const void*)fwd_megakernel, 512, LDS_BYTES) != hipSuccess || per_cu < 1)
            fprintf(stderr, "kernel_launch: note: occupancy query reports %d workgroups per CU\n", per_cu);
        (void)hipGetLastError();
        grid = cus;
    }
    if (grid < 0) return;
    if (hipMemsetAsync((char*)d_ws + WS_CTL, 0, CTL_ZERO_BYTES, stream) != hipSuccess) { fprintf(stderr, "kernel_launch: memset failed\n"); return; }
    Args a{};
    for (int i = 0; i < 17; ++i) a.in[i] = d_in[i];
    a.out = (float*)d_out; a.ws = (unsigned char*)d_ws;
    hipLaunchKernelGGL(fwd_megakernel, dim3(grid), dim3(512), LDS_BYTES, stream, a);
    const hipError_t le = hipPeekAtLastError();
    if (le != hipSuccess) fprintf(stderr, "kernel_launch: launch failed: %s\n", hipGetErrorName(le));
}
```
